# Optimizing an MI355X kernel written in HIP

```python
import jax, jax.numpy as jnp
from jax import lax
import numpy as np

D_MODEL = 4096
BATCH = 4
SEQ = 4096
DEPTH = 1

CHUNK = 64
LEFT_CHUNKS = 8
BAND = (LEFT_CHUNKS + 1) * CHUNK
LEFT_PAD = LEFT_CHUNKS * CHUNK
POOL_WIDTH = D_MODEL // 4
POOL_WINDOWS = (2, 4, 8, 16)
N_POOL_GROUPS = len(POOL_WINDOWS)
POOL_GROUP_DIM = POOL_WIDTH // N_POOL_GROUPS
ATTN_WIDTH = D_MODEL - POOL_WIDTH
HEAD_DIM = 128
N_HEADS = ATTN_WIDTH // HEAD_DIM
MAX_REL = 128
N_REL = 2 * MAX_REL + 1
IN_WIDTH = POOL_WIDTH + 3 * ATTN_WIDTH
N_GROUPS = 4
EXPERTS_PER_GROUP = 8
N_EXPERTS = N_GROUPS * EXPERTS_PER_GROUP
TOP_K = 2
D_EXPERT = D_MODEL // 4
ROW_BLOCK = 128
EPS = 1e-6
MASK_VALUE = -1e30

kernel_name = "hybrid_pool_chunkattn_hmoe"


def _rmsnorm(x, g):
    xf = x.astype(jnp.float32)
    y = xf * lax.rsqrt(jnp.mean(xf * xf, axis=-1, keepdims=True) + EPS)
    return (y * g.astype(jnp.float32)).astype(x.dtype)


def _pool_mixer(u, group_w, scale):
    B, S, _ = u.shape
    uf = u.astype(jnp.float32)
    csum = jnp.concatenate([jnp.zeros((B, 1, POOL_WIDTH), jnp.float32),
                            jnp.cumsum(uf, axis=1)], axis=1)
    t = jnp.arange(S)
    outs = []
    for gi, w in enumerate(POOL_WINDOWS):
        sl = slice(gi * POOL_GROUP_DIM, (gi + 1) * POOL_GROUP_DIM)
        lo = jnp.maximum(t + 1 - w, 0)
        count = (t + 1 - lo).astype(jnp.float32)[None, :, None]
        outs.append((csum[:, 1:, sl] - csum[:, lo, sl]) / count - uf[..., sl])
    pooled = jnp.stack(outs, axis=2)
    mixed = jnp.einsum('bsgc,gcd->bsgd', pooled, group_w.astype(jnp.float32))
    return (mixed.reshape(B, S, POOL_WIDTH) * scale.astype(jnp.float32)).astype(u.dtype)


def _chunked_attention(q, k, v, q_gain, k_gain, rel_bias):
    B, S, H, Dh = q.shape
    n_chunks = S // CHUNK
    q = _rmsnorm(q, q_gain)
    k = _rmsnorm(k, k_gain)
    pad = ((0, 0), (0, 0), (LEFT_PAD, 0), (0, 0))
    kp = jnp.pad(k.transpose(0, 2, 1, 3), pad)
    vp = jnp.pad(v.transpose(0, 2, 1, 3), pad)
    qc = q.reshape(B, n_chunks, CHUNK, H, Dh).transpose(1, 0, 3, 2, 4)
    qi = jnp.arange(CHUNK)[:, None]
    kj = jnp.arange(BAND)[None, :]
    rel_idx = jnp.clip(qi + LEFT_PAD - kj, -MAX_REL, MAX_REL) + MAX_REL
    bias = rel_bias[:, rel_idx].astype(jnp.float32)
    scale = HEAD_DIM ** -0.5

    def one_chunk(args):
        c, qb = args
        kb = lax.dynamic_slice_in_dim(kp, c * CHUNK, BAND, axis=2)
        vb = lax.dynamic_slice_in_dim(vp, c * CHUNK, BAND, axis=2)
        s = jnp.einsum('bhqd,bhkd->bhqk', qb, kb,
                       preferred_element_type=jnp.float32) * scale + bias
        valid = kj >= LEFT_PAD - c * CHUNK
        s = jnp.where(valid[None, None], s, MASK_VALUE)
        p = jax.nn.softmax(s, axis=-1)
        return jnp.einsum('bhqk,bhkd->bhqd', p.astype(vb.dtype), vb)

    o = lax.map(one_chunk, (jnp.arange(n_chunks), qc))
    return o.transpose(1, 0, 3, 2, 4).reshape(B, S, H * Dh)


def _hier_moe(h, w_rg, b_rg, w_re, b_re, w_gate, w_up, w_down):
    B, S, D = h.shape
    N = B * S
    xf = h.reshape(N, D)
    lg = jnp.matmul(xf, w_rg, preferred_element_type=jnp.float32) + b_rg.astype(jnp.float32)
    pg = jax.nn.softmax(lg, axis=-1)
    g_idx = jnp.argmax(lg, axis=-1)
    p_sel = jnp.take_along_axis(pg, g_idx[:, None], axis=1)
    le_all = jnp.einsum('nd,gde->nge', xf, w_re,
                        preferred_element_type=jnp.float32) + b_re.astype(jnp.float32)
    le = jnp.take_along_axis(le_all, g_idx[:, None, None], axis=1)[:, 0]
    top_v, top_i = lax.top_k(le, TOP_K)
    gates = p_sel * jax.nn.softmax(top_v, axis=-1)
    expert = g_idx[:, None].astype(jnp.int32) * EXPERTS_PER_GROUP + top_i.astype(jnp.int32)

    A = N * TOP_K
    e_flat = expert.reshape(A)
    g_flat = gates.reshape(A)
    tok_flat = jnp.repeat(jnp.arange(N, dtype=jnp.int32), TOP_K)
    order = jnp.argsort(e_flat, stable=True)
    e_sorted = e_flat[order]
    counts = jnp.bincount(e_flat, length=N_EXPERTS)
    start = jnp.cumsum(counts) - counts
    pcounts = ((counts + ROW_BLOCK - 1) // ROW_BLOCK) * ROW_BLOCK
    pend = jnp.cumsum(pcounts)
    pstart = pend - pcounts
    dest = pstart[e_sorted] + (jnp.arange(A, dtype=jnp.int32) - start[e_sorted])
    P = A + N_EXPERTS * ROW_BLOCK
    NB = P // ROW_BLOCK
    buf_tok = jnp.full((P,), N, jnp.int32).at[dest].set(tok_flat[order])
    buf_gate = jnp.zeros((P,), jnp.float32).at[dest].set(g_flat[order])
    block_start = jnp.arange(NB, dtype=jnp.int32) * ROW_BLOCK
    block_e = jnp.minimum(jnp.sum(block_start[:, None] >= pend[None, :], axis=1), N_EXPERTS - 1)
    x_pad = jnp.concatenate([xf, jnp.zeros((1, D), xf.dtype)], axis=0)

    def run_block(args):
        e, tb, gb = args
        xb = x_pad[tb]
        a = jax.nn.silu(xb @ w_gate[e]) * (xb @ w_up[e])
        return (a @ w_down[e]) * gb[:, None].astype(xb.dtype)

    ys = lax.map(run_block, (block_e, buf_tok.reshape(NB, ROW_BLOCK),
                             buf_gate.reshape(NB, ROW_BLOCK)))
    out = jnp.zeros((N + 1, D), jnp.float32).at[buf_tok].add(
        ys.reshape(P, D).astype(jnp.float32))[:N]
    return out.astype(h.dtype).reshape(B, S, D)


def setup_inputs(seed: int = 0) -> dict:
    key = jax.random.key(seed)
    ks = jax.random.split(key, 18)
    f32 = jnp.float32
    nrm = lambda k, shape, s: jax.random.normal(k, shape, f32) * s
    return {
        "x": nrm(ks[0], (BATCH, SEQ, D_MODEL), 1.0),
        "norm1_gain": 1.0 + nrm(ks[1], (DEPTH, D_MODEL), 0.02),
        "w_in": nrm(ks[2], (DEPTH, D_MODEL, IN_WIDTH), D_MODEL ** -0.5),
        "pool_group_w": nrm(ks[3], (DEPTH, N_POOL_GROUPS, POOL_GROUP_DIM, POOL_GROUP_DIM),
                            POOL_GROUP_DIM ** -0.5),
        "pool_scale": 1.0 + nrm(ks[4], (DEPTH, POOL_WIDTH), 0.02),
        "q_norm_gain": 1.0 + nrm(ks[5], (DEPTH, HEAD_DIM), 0.02),
        "k_norm_gain": 1.0 + nrm(ks[6], (DEPTH, HEAD_DIM), 0.02),
        "rel_bias": nrm(ks[7], (DEPTH, N_HEADS, N_REL), 0.5),
        "w_out": nrm(ks[8], (DEPTH, D_MODEL, D_MODEL), D_MODEL ** -0.5),
        "norm2_gain": 1.0 + nrm(ks[9], (DEPTH, D_MODEL), 0.02),
        "w_router_group": nrm(ks[10], (DEPTH, D_MODEL, N_GROUPS), D_MODEL ** -0.5),
        "b_router_group": nrm(ks[11], (DEPTH, N_GROUPS), 0.01),
        "w_router_expert": nrm(ks[12], (DEPTH, N_GROUPS, D_MODEL, EXPERTS_PER_GROUP),
                               D_MODEL ** -0.5),
        "b_router_expert": nrm(ks[13], (DEPTH, N_GROUPS, EXPERTS_PER_GROUP), 0.01),
        "w_expert_gate": nrm(ks[14], (DEPTH, N_EXPERTS, D_MODEL, D_EXPERT), D_MODEL ** -0.5),
        "w_expert_up": nrm(ks[15], (DEPTH, N_EXPERTS, D_MODEL, D_EXPERT), D_MODEL ** -0.5),
        "w_expert_down": nrm(ks[16], (DEPTH, N_EXPERTS, D_EXPERT, D_MODEL), D_EXPERT ** -0.5),
    }


def reference(x, norm1_gain, w_in, pool_group_w, pool_scale, q_norm_gain, k_norm_gain,
              rel_bias, w_out, norm2_gain, w_router_group, b_router_group, w_router_expert,
              b_router_expert, w_expert_gate, w_expert_up, w_expert_down):
    B, S, _ = x.shape
    for l in range(DEPTH):
        h = _rmsnorm(x, norm1_gain[l])
        proj = h @ w_in[l]
        u = proj[..., :POOL_WIDTH]
        q = proj[..., POOL_WIDTH:POOL_WIDTH + ATTN_WIDTH].reshape(B, S, N_HEADS, HEAD_DIM)
        k = proj[..., POOL_WIDTH + ATTN_WIDTH:POOL_WIDTH + 2 * ATTN_WIDTH].reshape(
            B, S, N_HEADS, HEAD_DIM)
        v = proj[..., POOL_WIDTH + 2 * ATTN_WIDTH:].reshape(B, S, N_HEADS, HEAD_DIM)
        y_pool = _pool_mixer(u, pool_group_w[l], pool_scale[l])
        y_attn = _chunked_attention(q, k, v, q_norm_gain[l], k_norm_gain[l], rel_bias[l])
        x = x + jnp.concatenate([y_pool, y_attn], axis=-1) @ w_out[l]
        h2 = _rmsnorm(x, norm2_gain[l])
        x = x + _hier_moe(h2, w_router_group[l], b_router_group[l], w_router_expert[l],
                          b_router_expert[l], w_expert_gate[l], w_expert_up[l],
                          w_expert_down[l])
    return x
```

```cpp
#include <hip/hip_runtime.h>
#include <stdint.h>
#include <stdio.h>

#ifndef MK_LAUNCHES
#define MK_LAUNCHES 1
#endif

#ifndef MK_REPEAT
#define MK_REPEAT -1
#endif
#ifndef MK_REPEAT_FLAGS
#define MK_REPEAT_FLAGS 0
#endif
#ifndef MK_STOP
#define MK_STOP 11
#endif
#define LAS __attribute__((address_space(3)))
typedef unsigned short bf16_t;
typedef short bf16x8 __attribute__((ext_vector_type(8)));
typedef short s16x4 __attribute__((ext_vector_type(4)));
typedef float f32x4 __attribute__((ext_vector_type(4)));
typedef float f32x16 __attribute__((ext_vector_type(16)));
typedef unsigned u32x4 __attribute__((ext_vector_type(4)));
typedef unsigned u32x2 __attribute__((ext_vector_type(2)));
typedef int i32x4 __attribute__((ext_vector_type(4)));
typedef int i32x8 __attribute__((ext_vector_type(8)));

constexpr int NTOK = 16384, DM = 4096, SEQ = 4096, INW = 10240, PW = 1024, AW = 3072, NH = 24, HD = 128, NREL = 257;
constexpr int NE = 32, DE = 1024, ECAP = 1536, ETILES = ECAP / 256, MAXROWS = NE * ECAP, MAXTILES = NE * ETILES;
constexpr int LDK8 = DM + 128, LDE8 = DE + 128;
constexpr float Y_SCALE = 64.f;
constexpr float WGU_SCALE = 256.f, WD_SCALE = 128.f, A_SCALE = 32.f;
constexpr int LDM = 2048 + 3072 + 128;
constexpr float Q8_SCALE = 32.f, K8_SCALE = 8.f;
constexpr float WIN_SCALE = 256.f, WOUT_SCALE = 256.f, YA_SCALE = 64.f;
constexpr int LDK = DM + 64, LDE = DE + 64;
constexpr float EPS = 1e-6f, LOG2E = 1.4426950408889634f;
constexpr float QSCALE = 0.08838834764831845f * 1.4426950408889634f;
constexpr int NPH = 11;

constexpr size_t MiB = 1u << 20;
constexpr size_t WS_CTL = 0, CTL_BYTES = 1 * MiB;
constexpr size_t WS_WINU = 1 * MiB;
constexpr size_t WS_WIN8 = WS_WINU + 9 * MiB;
constexpr size_t WS_WOUT = WS_WIN8 + 38 * MiB;
constexpr size_t WS_WGU = WS_WOUT + 21 * MiB;
constexpr size_t WS_WD = WS_WGU + 264 * MiB;
constexpr size_t WS_WR = WS_WD + 144 * MiB;
constexpr size_t WS_GW = WS_WR + 3 * MiB;
constexpr size_t WS_H = WS_GW + 1 * MiB;
constexpr size_t WS_H8 = WS_H + 130 * MiB;
constexpr size_t WS_U = WS_H8 + 67 * MiB;
constexpr size_t WS_Q = WS_U + 32 * MiB;
constexpr size_t WS_K = WS_Q + 96 * MiB;
constexpr size_t WS_V = WS_K + 96 * MiB;
constexpr size_t WS_POOLED = WS_V + 96 * MiB;
constexpr size_t WS_XS = WS_U;
constexpr size_t WS_YCAT = WS_POOLED + 32 * MiB;
constexpr size_t WS_ABUF = WS_YCAT;
constexpr size_t WS_LOG = WS_YCAT + 82 * MiB;
constexpr size_t WS_SSQ = WS_LOG + 16 * MiB;
constexpr size_t WS_TOK = WS_SSQ + 4 * MiB;
constexpr size_t WS_ROW = WS_TOK + 1 * MiB;
constexpr size_t WS_Y = WS_ROW + 1 * MiB;
constexpr size_t WS_END = WS_Y + 192 * MiB;
static_assert(WS_END <= 2048 * MiB, "workspace map");
constexpr int CW_BAR = 1024;
constexpr int CW_CNT = 8192;
constexpr int CW_PAN = 16384, CW_P8DONE = 16384 + 256;
constexpr int TM_E = 0, TM_POS = 2 * NTOK, TM_GATE = 4 * NTOK, TM_DEST = 6 * NTOK, TM_RSTD = 8 * NTOK;
constexpr int RM_GATE = 0, RM_RSTD = MAXROWS;

constexpr int LDS_STAGE = 0, STAGE_BYTES = 131072;
constexpr int LDS_XCH = 131072;
constexpr int LDS_TAB = LDS_XCH + 8192;
constexpr int LDS_MISC = LDS_TAB + 2048;
constexpr int LDS_BYTES = 147456;
static_assert(LDS_MISC + 256 <= LDS_BYTES, "lds map");

__device__ __forceinline__ unsigned cvt_pk_bf16(float lo, float hi) { unsigned r; asm volatile("v_cvt_pk_bf16_f32 %0, %1, %2" : "=v"(r) : "v"(lo), "v"(hi)); return r; }
__device__ __forceinline__ float clamp448(float v) { return fminf(fmaxf(v, -448.f), 448.f); }
__device__ __forceinline__ unsigned pk4_fp8(float a, float b, float c, float d) { int r = __builtin_amdgcn_cvt_pk_fp8_f32(clamp448(a), clamp448(b), 0, false); r = __builtin_amdgcn_cvt_pk_fp8_f32(clamp448(c), clamp448(d), r, true); return (unsigned)r; }
__device__ __forceinline__ u32x2 bf16x8_to_fp8(u32x4 v, float sc) { u32x2 o;
    o.x = pk4_fp8(__uint_as_float(v[0] << 16) * sc, __uint_as_float(v[0] & 0xffff0000u) * sc, __uint_as_float(v[1] << 16) * sc, __uint_as_float(v[1] & 0xffff0000u) * sc);
    o.y = pk4_fp8(__uint_as_float(v[2] << 16) * sc, __uint_as_float(v[2] & 0xffff0000u) * sc, __uint_as_float(v[3] << 16) * sc, __uint_as_float(v[3] & 0xffff0000u) * sc); return o; }
__device__ __forceinline__ float bf2f(unsigned short b) { return __uint_as_float(((unsigned)b) << 16); }
__device__ __forceinline__ float xor_lane(float v, int lane, int mask) { return __int_as_float(__builtin_amdgcn_ds_bpermute((lane ^ mask) << 2, __float_as_int(v))); }
__device__ __forceinline__ float wave_sum(float v) {
#pragma unroll
    for (int o = 1; o < 64; o <<= 1) v += __shfl_xor(v, o);
    return v;
}

__device__ __forceinline__ int lane_() { int l; asm volatile("v_mbcnt_lo_u32_b32 %0, -1, 0\n\tv_mbcnt_hi_u32_b32 %0, -1, %0" : "=v"(l)); return l; }
#define XB_TMO      128
#define XB_XCNT(j)  (256  + 64 * (j))
#define XB_XSUB(j)  (1280 + 64 * (j))
#define XB_XGEN(j)  (2304 + 64 * (j))
#define XB_TOP      3328
#define XB_TOPGEN   3392
#define XCD_BAR_WORDS 3456
#define XB_SPIN_CAP (1u << 18)
__device__ __forceinline__ unsigned xb_ld(unsigned* p)              { return __hip_atomic_load(p, __ATOMIC_RELAXED, __HIP_MEMORY_SCOPE_AGENT); }
__device__ __forceinline__ unsigned xb_add(unsigned* p, unsigned v) { return __hip_atomic_fetch_add(p, v, __ATOMIC_RELAXED, __HIP_MEMORY_SCOPE_AGENT); }
__device__ __forceinline__ unsigned xb_xcc_id() { return (unsigned)__builtin_amdgcn_s_getreg((3 << 11) | 20) & 0xFu; }
#define XB_SPIN(cond, bar) do { unsigned _sp = 0; while (cond) { __builtin_amdgcn_s_sleep(1); \
    if ((++_sp & 255u) == 0u) { if (xb_ld(&(bar)[XB_TMO])) break; if (_sp > XB_SPIN_CAP) { atomicAdd(&(bar)[XB_TMO], 1u); break; } } } } while (0)
struct XcdBarrier { unsigned* bar; unsigned x; volatile LAS unsigned* st; };
__device__ __forceinline__ XcdBarrier xcd_barrier_post(unsigned* bar, volatile LAS unsigned* st, bool leader) {
    XcdBarrier b; b.bar = bar; b.x = xb_xcc_id(); b.st = st;
    if (leader) (void)xb_add(&bar[XB_XCNT(b.x)], 1u);
    return b;
}
__device__ __forceinline__ void xcd_barrier_complete(unsigned* bar, unsigned x, unsigned& nloc, unsigned& nx) {
    const unsigned G = gridDim.x * gridDim.y * gridDim.z;
    unsigned sum, cnt, mine, sp = 0u;
    for (;;) {
        sum = 0u; cnt = 0u; mine = 0u;
#pragma unroll
        for (unsigned j = 0; j < 16; ++j) { const unsigned c = xb_ld(&bar[XB_XCNT(j)]); sum += c; cnt += (c > 0u) ? 1u : 0u; mine = (j == x) ? c : mine; }
        if (sum == G) break;
        __builtin_amdgcn_s_sleep(1);
        if ((++sp & 255u) == 0u) { if (xb_ld(&bar[XB_TMO])) break; if (sp > XB_SPIN_CAP) { atomicAdd(&bar[XB_TMO], 1u); break; } }
    }
    nloc = mine > 0u ? mine : 1u; nx = cnt > 0u ? cnt : 1u;
}
__device__ __forceinline__ void xcd_barrier(const XcdBarrier& b, bool leader) {
    asm volatile("s_waitcnt vmcnt(0)" ::: "memory");
    __syncthreads();
    if (leader) {
        unsigned* bar = b.bar;
        __builtin_amdgcn_s_waitcnt(0);
        unsigned nloc = b.st[0], nx = b.st[1];
        if (nloc == 0u) { xcd_barrier_complete(bar, b.x, nloc, nx); b.st[0] = nloc; b.st[1] = nx; }
        const unsigned old = xb_add(&bar[XB_XSUB(b.x)], 1u);
        const unsigned gen = old / nloc;
        if (old + 1u == (gen + 1u) * nloc) {
            __builtin_amdgcn_fence(__ATOMIC_RELEASE, "agent");
            asm volatile("s_waitcnt vmcnt(0)" ::: "memory");
            const unsigned og = xb_add(&bar[XB_TOP], 1u);
            if (og + 1u == (gen + 1u) * nx) xb_add(&bar[XB_TOPGEN], 1u);
            else XB_SPIN(xb_ld(&bar[XB_TOPGEN]) == gen, bar);
        } else {
            XB_SPIN(xb_ld(&bar[XB_TOPGEN]) == gen, bar);
        }
        __builtin_amdgcn_fence(__ATOMIC_ACQUIRE, "agent");
        asm volatile("s_waitcnt vmcnt(0)" ::: "memory");
    }
    __syncthreads();
}

namespace pg8 {
constexpr int BM = 256, BK = 64, HALF = 128, HTB = HALF * BK * 2;
__device__ __forceinline__ int lds_byte(int r, int c) { const int st = (r >> 4) * 2 + (c >> 5), rr = r & 15, cc = c & 31, ob = rr * 64 + cc * 2; return st * 1024 + (ob ^ (((ob >> 9) & 1) << 5)); }
__device__ __forceinline__ void stage_rc(int b, int& R, int& C) { const int st = b / 1024, sb = b % 1024, swz = sb ^ (((sb >> 9) & 1) << 5); R = (st >> 1) * 16 + swz / 64; C = (st & 1) * 32 + (swz % 64) / 2; }
__device__ __forceinline__ int perm32(int rho) { const int n = rho >> 4, i = rho & 15; return 8 * (i >> 2) + 4 * n + (i & 3); }

struct Unit { const char* A; const char* B; int pm, pn; };
struct Shape { int nt; unsigned lda, ldb; };

template <int NB, int SA, int SB, class Epi, class Sched, bool HK = false>
__device__ __forceinline__ void gemm_phase(LAS unsigned char* lds, const int wid, const Shape g, const Sched& S, const Epi& E) {
    const int lane = lane_(), tid = wid * 64 + lane, wr = wid >> 2, wc = wid & 3, fr = lane & 15, fq = lane >> 4;
    const int nt = g.nt;
    unsigned voffA, voffB;
    { int R, C; stage_rc(tid * 16, R, C); const int Rb = (R & ~31) + perm32(R & 31); voffA = (unsigned)R * g.lda + (unsigned)C * 2u; voffB = (unsigned)Rb * g.ldb + (unsigned)C * 2u; }
    const size_t r64voffA = (size_t)64 * g.lda, r64voffB = (size_t)64 * g.ldb;
    const size_t kstep = (size_t)(BK * 2);
    const size_t hstepA = (size_t)HALF * g.lda, hstepB = (size_t)HALF * g.ldb;
    const unsigned ldsw = (unsigned)wid * 1024u;
    const int aoff = lds_byte(wr * 64 + fr, fq * 8), boff = lds_byte(wc * 32 + fr, fq * 8);
#define PG8_SA(b, h) (((b) * 2 + (h)) * HTB)
#define PG8_SB(b, h) ((4 + (b) * 2 + (h)) * HTB)
#define PG8_STAGE(bufoff, gbase, voff) do { _Pragma("unroll") for (int _i = 0; _i < 2; ++_i) { unsigned vo_ = (voff); asm volatile("" : "+v"(vo_)); \
        __builtin_amdgcn_global_load_lds((const unsigned*)((const char*)(gbase) + (_i ? r64##voff : (size_t)0) + vo_), (LAS unsigned*)(lds + (bufoff) + ldsw + _i * 8192), 16, 0, 0); } } while (0)
#define PG8_LDA(dst, b, h) do { _Pragma("unroll") for (int m = 0; m < 4; ++m) _Pragma("unroll") for (int k = 0; k < 2; ++k) dst[m][k] = *(const LAS bf16x8*)(lds + PG8_SA(b, h) + aoff + m * 2048 + k * 1024); } while (0)
#define PG8_LDB(dst, b, h) do { _Pragma("unroll") for (int n = 0; n < 2; ++n) _Pragma("unroll") for (int k = 0; k < 2; ++k) dst[n][k] = *(const LAS bf16x8*)(lds + PG8_SB(b, h) + boff + n * 2048 + k * 1024); } while (0)
#define PG8_MMA(ai, bj, At, Bt) do { __builtin_amdgcn_s_setprio(1); _Pragma("unroll") for (int m = 0; m < 4; ++m) _Pragma("unroll") for (int n = 0; n < 2; ++n) _Pragma("unroll") for (int k = 0; k < 2; ++k) \
        acc[ai][bj][m][n] = __builtin_amdgcn_mfma_f32_16x16x32_bf16(Bt[n][k], At[m][k], acc[ai][bj][m][n], 0, 0, 0); __builtin_amdgcn_s_setprio(0); } while (0)
#define PG8_MMA8(ai, bj, At, Bt) do { __builtin_amdgcn_s_setprio(1); _Pragma("unroll") for (int m = 0; m < 4; ++m) _Pragma("unroll") for (int n = 0; n < 2; ++n) { \
        const i32x8 a8_ = __builtin_shufflevector(__builtin_bit_cast(i32x4, At[m][0]), __builtin_bit_cast(i32x4, At[m][1]), 0, 1, 2, 3, 4, 5, 6, 7); \
        const i32x8 b8_ = __builtin_shufflevector(__builtin_bit_cast(i32x4, Bt[n][0]), __builtin_bit_cast(i32x4, Bt[n][1]), 0, 1, 2, 3, 4, 5, 6, 7); \
        acc[ai][bj][m][n] = __builtin_amdgcn_mfma_scale_f32_16x16x128_f8f6f4(b8_, a8_, acc[ai][bj][m][n], 0, 0, 0, SA, 0, SB); } __builtin_amdgcn_s_setprio(0); } while (0)

#define PG8_WAIT_V(n) asm volatile("s_waitcnt vmcnt(" #n ")" ::: "memory")
#define PG8_WAIT_L(n) asm volatile("s_waitcnt lgkmcnt(" #n ")" ::: "memory")
#define PG8_BAR __builtin_amdgcn_s_barrier()
#define PG8_SCHED __builtin_amdgcn_sched_barrier(0)
    Unit cur, nxt; int ui = 0;
    if (!S.next(0, cur)) return;
    f32x4 acc[2][2][4][2];
#pragma unroll
    for (int a = 0; a < 2; ++a)
#pragma unroll
        for (int b = 0; b < 2; ++b)
#pragma unroll
            for (int m = 0; m < 4; ++m)
#pragma unroll
                for (int n = 0; n < 2; ++n) acc[a][b][m][n] = (f32x4){0.f, 0.f, 0.f, 0.f};
    bf16x8 At[4][2], B0[2][2], B1[2][2];
    const char* cA = cur.A; const char* cB = cur.B;
    if constexpr (HK) S.a_ready(cur);
    PG8_STAGE(PG8_SB(0, 0), cB, voffB); PG8_STAGE(PG8_SB(0, 1), cB + hstepB, voffB); PG8_STAGE(PG8_SA(0, 0), cA, voffA); PG8_STAGE(PG8_SA(0, 1), cA + hstepA, voffA);
    if (wr == 1) PG8_BAR;
    PG8_WAIT_V(2); PG8_BAR;
    PG8_STAGE(PG8_SB(1, 0), cB + kstep, voffB); PG8_STAGE(PG8_SA(1, 0), cA + kstep, voffA); PG8_STAGE(PG8_SB(1, 1), cB + hstepB + kstep, voffB);
    PG8_WAIT_V(6); PG8_BAR;
    for (;;) {
        const bool has_next = S.next(ui + 1, nxt);
        const char* nA = has_next ? nxt.A : cA; const char* nB = has_next ? nxt.B : cB;
#define PG8_ITER(MM) do { \
            const bool last = (t == nt - 2); \
            const char* a1 = cA + (size_t)(t + 1) * kstep; \
            const char* a2 = last ? nA : cA + (size_t)(t + 2) * kstep; const char* b2 = last ? nB : cB + (size_t)(t + 2) * kstep; \
            const char* a3 = a2 + kstep; const char* b3 = b2 + kstep; \
            PG8_LDB(B0, 0, 0); PG8_LDB(B1, 0, 1); PG8_SCHED; PG8_LDA(At, 0, 0); PG8_STAGE(PG8_SA(1, 1), a1 + hstepA, voffA); \
            PG8_WAIT_V(8); PG8_WAIT_L(0); PG8_BAR; MM(0, 0, At, B0); MM(0, 1, At, B1); PG8_BAR; PG8_SCHED; \
            PG8_LDA(At, 0, 1); PG8_STAGE(PG8_SB(0, 0), b2, voffB); PG8_STAGE(PG8_SB(0, 1), b2 + hstepB, voffB); PG8_STAGE(PG8_SA(0, 0), a2, voffA); \
            PG8_WAIT_V(8); PG8_WAIT_L(0); PG8_BAR; MM(1, 0, At, B0); MM(1, 1, At, B1); PG8_BAR; PG8_SCHED; \
            PG8_LDB(B0, 1, 0); PG8_LDB(B1, 1, 1); PG8_SCHED; PG8_LDA(At, 1, 0); PG8_STAGE(PG8_SA(0, 1), a2 + hstepA, voffA); \
            PG8_WAIT_V(8); PG8_WAIT_L(0); PG8_BAR; MM(0, 0, At, B0); MM(0, 1, At, B1); PG8_BAR; PG8_SCHED; \
            PG8_LDA(At, 1, 1); PG8_STAGE(PG8_SB(1, 0), b3, voffB); PG8_STAGE(PG8_SB(1, 1), b3 + hstepB, voffB); PG8_STAGE(PG8_SA(1, 0), a3, voffA); \
            PG8_WAIT_V(8); PG8_WAIT_L(0); PG8_BAR; MM(1, 0, At, B0); MM(1, 1, At, B1); PG8_BAR; PG8_SCHED; } while (0)
        int t = 0;
        if constexpr (NB != 0) {
            const int tb_end = NB < 0 ? nt : NB;
#pragma unroll 1
            for (; t < tb_end; t += 2) PG8_ITER(PG8_MMA);
        }
        if constexpr (NB >= 0) {
#pragma unroll 1
            for (; t < nt; t += 2) { if constexpr (HK) { if (t == nt - 2 && has_next) S.a_ready(nxt); } PG8_ITER(PG8_MMA8); }
        }
        if (wr == 0) PG8_BAR;
        E(acc, cur, wr, wc, fr, fq);
        if (!has_next) break;
#pragma unroll
        for (int a = 0; a < 2; ++a)
#pragma unroll
            for (int b = 0; b < 2; ++b)
#pragma unroll
                for (int m = 0; m < 4; ++m)
#pragma unroll
                    for (int n = 0; n < 2; ++n) acc[a][b][m][n] = (f32x4){0.f, 0.f, 0.f, 0.f};
        cur = nxt; cA = nA; cB = nB; ++ui;
        if (wr == 1) PG8_BAR;
    }
    PG8_WAIT_V(0);
    PG8_BAR;
#undef PG8_SA
#undef PG8_SB
#undef PG8_STAGE
#undef PG8_LDA
#undef PG8_LDB
#undef PG8_MMA
#undef PG8_MMA8
#undef PG8_ITER
#undef PG8_WAIT_V
#undef PG8_WAIT_L
#undef PG8_BAR
#undef PG8_SCHED
}

struct DenseOrder {
    const char* A; const char* B; unsigned lda, ldb; int nM, nN, nwg, G, c;
    __device__ __forceinline__ void init(const void* A_, const void* B_, unsigned lda_, unsigned ldb_, int M, int N, int G_, int c_) { A = (const char*)A_; B = (const char*)B_; lda = lda_; ldb = ldb_; nM = M / 256; nN = N / 256; nwg = nM * nN; G = G_; c = c_; }
    __device__ __forceinline__ bool next(int i, Unit& u) const {
        const long L = (long)i * G + c; if (L >= nwg) return false;
        int wgid = (int)L; { const int q = nwg / 8, r = nwg % 8, xcd = wgid % 8, off = wgid / 8; wgid = (xcd < r ? xcd * (q + 1) : r * (q + 1) + (xcd - r) * q) + off; }
        const int nig = 8 * nN, gid = wgid / nig, fm = gid * 8, gsz = (nM - fm) < 8 ? (nM - fm) : 8;
        u.pm = fm + ((wgid % nig) % gsz); u.pn = (wgid % nig) / gsz;
        u.A = A + (size_t)u.pm * 256 * lda; u.B = B + (size_t)u.pn * 256 * ldb; return true;
    }
};
struct PoolOrder {
    const char* A; const char* B; int G, c, n;
    __device__ __forceinline__ bool next(int i, Unit& u) const {
        const int L = i * G + c; if (L >= n) return false;
        u.pm = L >> 2; u.pn = L & 3;
        u.A = A + (size_t)u.pm * 256 * 2048 + (size_t)u.pn * 512; u.B = B + (size_t)u.pn * 256 * 512; return true;
    }
};
struct RouterOrder {
    const char* A; const char* B; int G, c;
    __device__ __forceinline__ bool next(int i, Unit& u) const {
        const int L = i * G + c; if (L >= 256) return false;
        u.pm = L >> 2; u.pn = L & 3;
        u.A = A + (size_t)u.pm * 256 * (LDK * 2) + (size_t)u.pn * 2048; u.B = B + (size_t)u.pn * 2048; return true;
    }
};
struct GroupedOrder {
    const char* A; const char* B; unsigned lda, ldb; int NT, NCT, rowsPerE, G, c; const LAS int* tile_e;
    __device__ __forceinline__ bool next(int i, Unit& u) const {
        const int U = NT * NCT; const int L = i * G + c; if (L >= U) return false;
        const int q = U / 8, xcd = L % 8, off = L / 8; const int wgid = xcd * q + off;
        const int ti = wgid / NCT, pn = wgid % NCT; const int code = __builtin_amdgcn_readfirstlane(tile_e[ti]); const int e = code >> 3, rt = e * ETILES + (code & 7);
        u.pm = rt; u.pn = pn; u.A = A + (size_t)rt * 256 * lda; u.B = B + ((size_t)e * rowsPerE + (size_t)pn * 256) * ldb; return true;
    }
};
struct DownOrder {
    const char* A; const char* B; unsigned lda, ldb; int NT, G, c, wv; const LAS int* tile_e; unsigned* pan; unsigned* done; volatile LAS unsigned* fl;
    __device__ __forceinline__ bool next(int i, Unit& u) const {
        const int U9 = NT * 16, U8 = NT * 8, r8 = (U8 + G - 1) / G, nB = U8 - G * (r8 - 1), nA = G - nB, E = ((nA & 7) == 0 && 2 * nA <= U9) ? 2 * nA : 0, Ur = U9 - E;
        int q;
        if (E && c >= nB && i < 2) q = (c - nB) + i * nA;
        else { const int j = (E && c >= nB) ? i - 2 : i; const int L = j * G + c; if (L >= Ur) return false; q = E + (((Ur & 7) == 0) ? (L % 8) * (Ur / 8) + L / 8 : L); }
        const int ti = q >> 4, pn = q & 15; const int code = __builtin_amdgcn_readfirstlane(tile_e[ti]); const int e = code >> 3, rt = e * ETILES + (code & 7);
        u.pm = rt; u.pn = pn; u.A = A + (size_t)rt * 256 * lda; u.B = B + ((size_t)e * DM + (size_t)pn * 256) * ldb; return true;
    }
    __device__ __forceinline__ void a_ready(const Unit& u) const {
        if (wv == 0) {
            if (fl[0] == 0u) { unsigned sp = 0;
                while ((unsigned)__builtin_amdgcn_readfirstlane(__hip_atomic_load(pan + u.pm, __ATOMIC_RELAXED, __HIP_MEMORY_SCOPE_AGENT)) < 64u) { __builtin_amdgcn_s_sleep(1); if (++sp > (1u << 20)) break; }
                if ((unsigned)__builtin_amdgcn_readfirstlane(__hip_atomic_load(done, __ATOMIC_RELAXED, __HIP_MEMORY_SCOPE_AGENT)) >= (unsigned)(NT * 64)) fl[0] = 1u; }
        }
        __builtin_amdgcn_s_barrier();
    }
};
}

using pg8::Unit;
#define ACC_T f32x4 (&acc)[2][2][4][2]
__device__ __forceinline__ u32x4 pack8(f32x4 v0, f32x4 v1) { u32x4 w; w.x = cvt_pk_bf16(v0[0], v0[1]); w.y = cvt_pk_bf16(v0[2], v0[3]); w.z = cvt_pk_bf16(v1[0], v1[1]); w.w = cvt_pk_bf16(v1[2], v1[3]); return w; }

struct EpiProj {
    bf16_t *U, *Q, *K, *V; const float *qg, *kg; LAS float* xch; int skip, pn0;
    __device__ __forceinline__ void operator()(ACC_T, const Unit& u, int wr, int wc, int fr, int fq) const {
        if (skip) return;
        float zf = 0.f; asm volatile("" : "+v"(fr), "+v"(fq), "+v"(zf));
        const int ln = fq * 16 + fr;
        const int pn = u.pn + pn0; bf16_t* dst; int ldc, colt; bool norm = false; const float* gain = qg; float gs = 1.f;
        if (pn < 4) { dst = U; ldc = PW; colt = pn * 256; }
        else if (pn < 16) { dst = Q; ldc = AW; colt = (pn - 4) * 256; norm = true; gain = qg; gs = QSCALE * Q8_SCALE; }
        else if (pn < 28) { dst = K; ldc = AW; colt = (pn - 16) * 256; norm = true; gain = kg; gs = K8_SCALE; }
        else { dst = V; ldc = AW; colt = (pn - 28) * 256; }
        const int row0 = u.pm * 256 + wr * 64 + fr, col0 = colt + wc * 32 + 8 * fq;
        if (norm) {
            LAS float* xw = xch + (wr * 128 + fr) * 8 + wc; const LAS float* xr_ = xch + (wr * 128 + fr) * 8;
            asm volatile("" : "+v"(xw), "+v"(xr_));
#pragma unroll
            for (int ai = 0; ai < 2; ++ai)
#pragma unroll
                for (int m = 0; m < 4; ++m)
#pragma unroll
                    for (int bj = 0; bj < 2; ++bj) {
                        const f32x4 x0 = acc[ai][bj][m][0], x1 = acc[ai][bj][m][1];
                        float s = (x0[0] * x0[0] + x0[1] * x0[1]) + (x0[2] * x0[2] + x0[3] * x0[3]) + (x1[0] * x1[0] + x1[1] * x1[1]) + (x1[2] * x1[2] + x1[3] * x1[3]);
                        s += xor_lane(s, ln, 16); s += xor_lane(s, ln, 32);
                        if (fq == 0) xw[(ai * 64 + m * 16) * 8 + bj * 4] = s;
                    }
            asm volatile("s_waitcnt lgkmcnt(0)" ::: "memory"); __builtin_amdgcn_s_barrier(); asm volatile("" ::: "memory");
            f32x4 g0 = *(const f32x4*)(gain + wc * 32 + 8 * fq), g1 = *(const f32x4*)(gain + wc * 32 + 8 * fq + 4);
            g0 *= gs; g1 *= gs;
#pragma unroll
            for (int ai = 0; ai < 2; ++ai)
#pragma unroll
                for (int m = 0; m < 4; ++m)
#pragma unroll
                    for (int bj = 0; bj < 2; ++bj) {
                        const f32x4 p = *(const LAS f32x4*)&xr_[(ai * 64 + m * 16) * 8 + bj * 4];
                        const float rstd = __builtin_amdgcn_rsqf(((p[0] + p[1]) + (p[2] + p[3])) * (1.0f / 128.0f) + (EPS + zf));
                        acc[ai][bj][m][0] *= g0 * rstd; acc[ai][bj][m][1] *= g1 * rstd;
                    }
        }
        if (norm) {
#pragma unroll
            for (int ai = 0; ai < 2; ++ai)
#pragma unroll
                for (int m = 0; m < 4; ++m) { unsigned char* rowp = (unsigned char*)dst + (size_t)(row0 + ai * 128 + m * 16) * AW + col0;
#pragma unroll
                    for (int bj = 0; bj < 2; ++bj) { const f32x4 v0 = acc[ai][bj][m][0], v1 = acc[ai][bj][m][1]; u32x2 w; w.x = pk4_fp8(v0[0], v0[1], v0[2], v0[3]); w.y = pk4_fp8(v1[0], v1[1], v1[2], v1[3]);
                        *(u32x2*)(rowp + bj * 128) = w; } }
            return;
        }
#pragma unroll
        for (int ai = 0; ai < 2; ++ai)
#pragma unroll
            for (int m = 0; m < 4; ++m) { bf16_t* rowp = dst + (size_t)(row0 + ai * 128 + m * 16) * ldc + col0;
#pragma unroll
                for (int bj = 0; bj < 2; ++bj) *(u32x4*)(rowp + bj * 128) = pack8(acc[ai][bj][m][0], acc[ai][bj][m][1]); }
    }
};
struct EpiPool {
    unsigned char* Y; const float* scale;
    __device__ __forceinline__ void operator()(ACC_T, const Unit& u, int wr, int wc, int fr, int fq) const {
        const int row0 = u.pm * 256 + wr * 64 + fr, col0 = u.pn * 256 + wc * 32 + 8 * fq;
        f32x4 sc[2][2];
#pragma unroll
        for (int bj = 0; bj < 2; ++bj)
#pragma unroll
            for (int n = 0; n < 2; ++n) sc[bj][n] = scale ? *(const f32x4*)(scale + col0 + bj * 128 + 4 * n) : (f32x4){1.f, 1.f, 1.f, 1.f};
#pragma unroll
        for (int ai = 0; ai < 2; ++ai)
#pragma unroll
            for (int m = 0; m < 4; ++m) { bf16_t* rowp = (bf16_t*)(Y + (size_t)(row0 + ai * 128 + m * 16) * LDM) + col0;
#pragma unroll
                for (int bj = 0; bj < 2; ++bj) *(u32x4*)(rowp + bj * 128) = pack8(acc[ai][bj][m][0] * sc[bj][0], acc[ai][bj][m][1] * sc[bj][1]); }
    }
};
struct EpiOut {
    const float* g1; const float* inv_rstd; bf16_t* x1b; float* ssq; int skip;
    __device__ __forceinline__ void operator()(ACC_T, const Unit& u, int wr, int wc, int fr, int fq) const {
        if (skip) return;
        const int row0 = u.pm * 256 + wr * 64 + fr, col0 = u.pn * 256 + wc * 32 + 8 * fq;
        f32x4 ig[2][2];
#pragma unroll
        for (int bj = 0; bj < 2; ++bj)
#pragma unroll
            for (int q = 0; q < 2; ++q) { const f32x4 g = *(const f32x4*)(g1 + col0 + bj * 128 + 4 * q);
                ig[bj][q] = (f32x4){__builtin_amdgcn_rcpf(g[0]), __builtin_amdgcn_rcpf(g[1]), __builtin_amdgcn_rcpf(g[2]), __builtin_amdgcn_rcpf(g[3])}; }
        u32x4 hr[8][2]; float xs[8];
#define EO_LOAD(it) do { const int r_ = row0 + ((it) >> 2) * 128 + ((it) & 3) * 16; const bf16_t* hp_ = x1b + (size_t)r_ * LDK + col0; \
        hr[it][0] = *(const u32x4*)hp_; hr[it][1] = *(const u32x4*)(hp_ + 128); xs[it] = inv_rstd[r_]; } while (0)
        EO_LOAD(0); EO_LOAD(1); EO_LOAD(2); EO_LOAD(3);
#pragma unroll
        for (int it = 0; it < 8; ++it) { const int ai = it >> 2, m = it & 3; const int r = row0 + ai * 128 + m * 16; float s = 0.f;
            if (it + 4 < 8) EO_LOAD(it + 4);
#pragma unroll
            for (int bj = 0; bj < 2; ++bj) { const u32x4 w = hr[it][bj]; const float sc = xs[it];
                const f32x4 h0 = {__uint_as_float(w.x << 16), __uint_as_float(w.x & 0xffff0000u), __uint_as_float(w.y << 16), __uint_as_float(w.y & 0xffff0000u)};
                const f32x4 h1 = {__uint_as_float(w.z << 16), __uint_as_float(w.z & 0xffff0000u), __uint_as_float(w.w << 16), __uint_as_float(w.w & 0xffff0000u)};
                const f32x4 v0 = acc[ai][bj][m][0] + h0 * ig[bj][0] * sc, v1 = acc[ai][bj][m][1] + h1 * ig[bj][1] * sc;
                s += (v0[0] * v0[0] + v0[1] * v0[1]) + (v0[2] * v0[2] + v0[3] * v0[3]) + (v1[0] * v1[0] + v1[1] * v1[1]) + (v1[2] * v1[2] + v1[3] * v1[3]);
                *(u32x4*)(x1b + (size_t)r * LDK + col0 + bj * 128) = pack8(v0, v1);
            }
            s += __shfl_xor(s, 16); s += __shfl_xor(s, 32);
            if (fq == 0) ssq[(size_t)r * 64 + u.pn * 4 + wc] = s;
            asm volatile("" ::: "memory"); }
#undef EO_LOAD
    }
};
struct EpiLogits {
    float* lg;
    __device__ __forceinline__ void operator()(ACC_T, const Unit& u, int wr, int wc, int fr, int fq) const {
        if (wc >= 2) return;
        const int row0 = u.pm * 256 + wr * 64 + fr, col0 = wc * 32 + 8 * fq;
#pragma unroll
        for (int ai = 0; ai < 2; ++ai)
#pragma unroll
            for (int m = 0; m < 4; ++m) { float* rowp = lg + (size_t)u.pn * (NTOK * 64) + (size_t)(row0 + ai * 128 + m * 16) * 64 + col0;
                *(f32x4*)(rowp) = acc[ai][0][m][0]; *(f32x4*)(rowp + 4) = acc[ai][0][m][1]; }
    }
};
struct EpiSwiglu {
    unsigned char* Ab; const float* row_gate; unsigned* pan; unsigned* done;
    __device__ __forceinline__ void operator()(ACC_T, const Unit& u, int wr, int wc, int fr, int fq) const {
        const int row0 = u.pm * 256 + wr * 64 + fr, col0 = u.pn * 128 + wc * 32 + 8 * fq;
#pragma unroll
        for (int ai = 0; ai < 2; ++ai)
#pragma unroll
            for (int m = 0; m < 4; ++m) { const int r = row0 + ai * 128 + m * 16; const float gt = row_gate[r] * A_SCALE; f32x4 a[2];
#pragma unroll
                for (int n = 0; n < 2; ++n) { const f32x4 gv = acc[ai][0][m][n], uv = acc[ai][1][m][n];
#pragma unroll
                    for (int j = 0; j < 4; ++j) { const float sg = __builtin_amdgcn_rcpf(1.0f + __builtin_amdgcn_exp2f(-gv[j] * LOG2E)); a[n][j] = gv[j] * sg * uv[j] * gt; } }
                u32x2 w; w.x = pk4_fp8(a[0][0], a[0][1], a[0][2], a[0][3]); w.y = pk4_fp8(a[1][0], a[1][1], a[1][2], a[1][3]);
                __hip_atomic_store((unsigned long long*)(Ab + (size_t)r * LDE8 + col0), ((unsigned long long)w.y << 32) | w.x, __ATOMIC_RELAXED, __HIP_MEMORY_SCOPE_AGENT); }
        asm volatile("s_waitcnt vmcnt(0)" ::: "memory");
        if (fr == 0 && fq == 0) { __hip_atomic_fetch_add(pan + u.pm, 1u, __ATOMIC_RELAXED, __HIP_MEMORY_SCOPE_AGENT); __hip_atomic_fetch_add(done, 1u, __ATOMIC_RELAXED, __HIP_MEMORY_SCOPE_AGENT); }
    }
};
struct EpiDown {
    unsigned char* Y;
    __device__ __forceinline__ void operator()(ACC_T, const Unit& u, int wr, int wc, int fr, int fq) const {
        const int row0 = u.pm * 256 + wr * 64 + fr, col0 = u.pn * 256 + wc * 32 + 8 * fq;
#pragma unroll
        for (int ai = 0; ai < 2; ++ai)
#pragma unroll
            for (int m = 0; m < 4; ++m) { const int r = row0 + ai * 128 + m * 16; unsigned char* rowp = Y + (size_t)r * DM + col0;
#pragma unroll
                for (int bj = 0; bj < 2; ++bj) { const f32x4 v0 = acc[ai][bj][m][0], v1 = acc[ai][bj][m][1]; u32x2 w; w.x = pk4_fp8(v0[0], v0[1], v0[2], v0[3]); w.y = pk4_fp8(v1[0], v1[1], v1[2], v1[3]);
                    *(u32x2*)(rowp + bj * 128) = w; } }
    }
};
struct Params { const float* in[17]; float* out; unsigned char* ws; int ph_lo, ph_hi, flags, pad; };
struct Frame {
    LAS unsigned char* lds; int wave, G, bx, vcu;
    unsigned char* ws; unsigned* ctl;
};
#define tid_() (F.wave * 64 + lane_())

struct TrTile { const float* src; bf16_t* dst; const float* kscale; int ldw, ldt, drow0, k0; float sc8; };
__device__ __forceinline__ TrTile tr_decode(const Params& P, unsigned char* ws, int t) {
    bf16_t* WinU = (bf16_t*)(ws + WS_WINU); unsigned char* Win8 = ws + WS_WIN8; unsigned char* Wout = ws + WS_WOUT; unsigned char* WguT = ws + WS_WGU; unsigned char* WdT = ws + WS_WD; bf16_t* GwT = (bf16_t*)(ws + WS_GW);
    constexpr int T_IN = 32 * 80, T_OUT = 32 * 32, T_GU = 32 * 512, T_D = 32 * 256;
    TrTile r; r.sc8 = 0.f; r.kscale = nullptr; int q = t;
    if (q < T_IN) { const int kt = q / 80, nt = q % 80; r.src = P.in[2] + (size_t)kt * 128 * INW + nt * 128; r.ldw = INW; r.k0 = kt * 128;
        if (nt < 8) { r.dst = WinU; r.ldt = LDK; r.drow0 = nt * 128; } else { r.dst = (bf16_t*)Win8; r.ldt = LDK8; r.drow0 = (nt - 8) * 128; r.sc8 = WIN_SCALE; }
        return r; } q -= T_IN;
    if (q < T_OUT) { const int kt = q / 32, nt = q % 32; r.src = P.in[8] + (size_t)kt * 128 * DM + nt * 128; r.ldw = DM; r.drow0 = nt * 128; r.k0 = kt * 128;
        if (kt < 8) { r.dst = (bf16_t*)(ws + WS_POOLED); r.ldt = PW; }
        else { r.dst = (bf16_t*)(Wout + 1024); r.ldt = LDM; r.sc8 = WOUT_SCALE; }
        return r; } q -= T_OUT;
    if (q < T_GU) { const int e = q / 512, r1 = q % 512, which = r1 / 256, r2 = r1 % 256, kt = r2 / 8, nt = r2 % 8;
        r.src = (which ? P.in[15] : P.in[14]) + (size_t)e * DM * DE + (size_t)kt * 128 * DE + nt * 128; r.ldw = DE; r.dst = (bf16_t*)(WguT + (size_t)e * 2048 * LDK8); r.ldt = LDK8; r.sc8 = WGU_SCALE; r.kscale = P.in[9]; r.drow0 = nt * 256 + which * 128; r.k0 = kt * 128; return r; } q -= T_GU;
    { const int e = q / 256, r1 = q % 256, kt = r1 / 32, nt = r1 % 32;
        r.src = P.in[16] + (size_t)e * DE * DM + (size_t)kt * 128 * DM + nt * 128; r.ldw = DM; r.dst = (bf16_t*)(WdT + (size_t)e * DM * LDE8); r.ldt = LDE8; r.sc8 = WD_SCALE; r.drow0 = nt * 128; r.k0 = kt * 128; return r; }
}
__device__ __forceinline__ void p0_prologue(const Frame& F, const Params& P) {
    const int tid = tid_(), lane = tid & 63;
    bf16_t* WrT = (bf16_t*)(F.ws + WS_WR); bf16_t* Hb = (bf16_t*)(F.ws + WS_H); unsigned char* H8 = F.ws + WS_H8;
    constexpr int T_ALL = 32 * 80 + 32 * 32 + 32 * 512 + 32 * 256;
    {
        LAS unsigned char* T = F.lds;
        const int l = lane, h = l >> 5, blk = (l >> 4) & 1, q = (l & 15) >> 2, p = l & 3, i16 = l & 15;
        const int nb = 2 * (F.wave & 3) + blk;
        const int lrow = tid >> 5, lc4 = tid & 31;
        f32x4 v[8];
        int t = F.vcu;
        TrTile cur = tr_decode(P, F.ws, t < T_ALL ? t : 0);
        if (t < T_ALL) {
#pragma unroll
            for (int j = 0; j < 8; ++j) v[j] = *(const f32x4*)(cur.src + (size_t)(lrow + 16 * j) * cur.ldw + lc4 * 4);
        }
        for (; t < T_ALL; t += F.G) {
            if (cur.kscale) {
#pragma unroll
                for (int j = 0; j < 8; ++j) v[j] *= cur.kscale[cur.k0 + lrow + 16 * j]; }
#pragma unroll
            for (int j = 0; j < 8; ++j) { u32x2 w; w.x = cvt_pk_bf16(v[j][0], v[j][1]); w.y = cvt_pk_bf16(v[j][2], v[j][3]); *(LAS u32x2*)(T + (lrow + 16 * j) * 320 + lc4 * 8) = w; }
            __syncthreads();
            const int tn = t + F.G; const TrTile nx = tr_decode(P, F.ws, tn < T_ALL ? tn : 0);
            if (tn < T_ALL) {
#pragma unroll
                for (int j = 0; j < 8; ++j) v[j] = *(const f32x4*)(nx.src + (size_t)(lrow + 16 * j) * nx.ldw + lc4 * 4);
            }
            if (cur.sc8 == 0.f) {
#pragma unroll
            for (int it = 0; it < 4; ++it) { const int kc8 = 8 * (F.wave >> 2) + 2 * it + h;
                const s16x4 lo = __builtin_amdgcn_ds_read_tr16_b64_v4i16((LAS s16x4*)(T + (8 * kc8 + q) * 320 + nb * 32 + 8 * p));
                const s16x4 hi = __builtin_amdgcn_ds_read_tr16_b64_v4i16((LAS s16x4*)(T + (8 * kc8 + 4 + q) * 320 + nb * 32 + 8 * p));
                const bf16x8 o = __builtin_shufflevector(lo, hi, 0, 1, 2, 3, 4, 5, 6, 7);
                *(bf16x8*)(cur.dst + (size_t)(cur.drow0 + nb * 16 + i16) * cur.ldt + cur.k0 + 8 * kc8) = o; }
            } else {
                unsigned char* d8 = (unsigned char*)cur.dst;
#pragma unroll
            for (int it = 0; it < 2; ++it) { const int kc16 = 4 * (F.wave >> 2) + 2 * it + h; u32x4 o;
#pragma unroll
                for (int hh = 0; hh < 2; ++hh) { const int kc8 = 2 * kc16 + hh;
                    const s16x4 lo = __builtin_amdgcn_ds_read_tr16_b64_v4i16((LAS s16x4*)(T + (8 * kc8 + q) * 320 + nb * 32 + 8 * p));
                    const s16x4 hi = __builtin_amdgcn_ds_read_tr16_b64_v4i16((LAS s16x4*)(T + (8 * kc8 + 4 + q) * 320 + nb * 32 + 8 * p));
                    const bf16x8 b8 = __builtin_shufflevector(lo, hi, 0, 1, 2, 3, 4, 5, 6, 7);
                    const u32x2 f8 = bf16x8_to_fp8(__builtin_bit_cast(u32x4, b8), cur.sc8); o[2 * hh] = f8.x; o[2 * hh + 1] = f8.y; }
                *(u32x4*)(d8 + (size_t)(cur.drow0 + nb * 16 + i16) * cur.ldt + cur.k0 + 16 * kc16) = o; }
            }
            __syncthreads();
            cur = nx;
        }
    }
    { const float* gw = P.in[3]; const float* ps = P.in[4]; bf16_t* Gs = (bf16_t*)(F.ws + WS_GW);
      for (int i = F.vcu * 512 + tid; i < 4 * 65536; i += F.G * 512) { const int g = i >> 16, d = i & 255; Gs[i] = (bf16_t)(cvt_pk_bf16(gw[i] * ps[g * 256 + d], 0.f) & 0xffffu); } }
    { const float* wrg = P.in[10]; const float* wre = P.in[12];
      for (int i = F.vcu * 512 + tid; i < 256 * DM; i += F.G * 512) { const int row = i >> 12, k = i & 4095; float v = 0.f;
          if (row < 4) v = wrg[k * 4 + row]; else if (row < 36) { const int g = (row - 4) >> 3, j = (row - 4) & 7; v = wre[((size_t)g * DM + k) * 8 + j]; }
          v *= P.in[9][k];
          WrT[(size_t)row * LDK + k] = (bf16_t)(cvt_pk_bf16(v, 0.f) & 0xffffu); } }
    { const float* x = P.in[0]; const float* g1 = P.in[1]; const int gw = F.vcu * 8 + F.wave, NGW = F.G * 8;
      for (int m = gw; m < NTOK; m += NGW) { const f32x4* xr = (const f32x4*)(x + (size_t)m * DM) + lane; f32x4 v[16]; float s = 0.f;
#pragma unroll
          for (int j = 0; j < 16; ++j) { v[j] = xr[64 * j]; s += (v[j][0] * v[j][0] + v[j][1] * v[j][1]) + (v[j][2] * v[j][2] + v[j][3] * v[j][3]); }
          const float rstd = __builtin_amdgcn_rsqf(wave_sum(s) * (1.0f / DM) + EPS);
          if (lane == 0) ((float*)(F.ws + WS_TOK))[TM_RSTD + m] = 1.0f / rstd;
          u32x2* o = (u32x2*)(Hb + (size_t)m * LDK) + lane; unsigned* o8 = (unsigned*)(H8 + (size_t)m * LDK8) + lane; const f32x4* gp = (const f32x4*)g1 + lane;
#pragma unroll
          for (int j = 0; j < 16; ++j) { const f32x4 gg = gp[64 * j]; const float h0 = v[j][0] * rstd * gg[0], h1 = v[j][1] * rstd * gg[1], h2 = v[j][2] * rstd * gg[2], h3 = v[j][3] * rstd * gg[3];
              u32x2 w; w.x = cvt_pk_bf16(h0, h1); w.y = cvt_pk_bf16(h2, h3); o[64 * j] = w; o8[64 * j] = pk4_fp8(h0, h1, h2, h3); } } }
}

template <int W> struct PoolV { u32x4 v[W]; };
template <int W> __device__ __forceinline__ void pooled_load(PoolV<W>& p, const bf16_t* U, int t, int s, int cc) {
#pragma unroll
    for (int j = 0; j < W; ++j) { const int d = (s - j) >= 0 ? j : 0; p.v[j] = *(const u32x4*)(U + (size_t)(t - d) * PW + cc * 8); }
}
template <int W> __device__ __forceinline__ void pooled_finish(const PoolV<W>& p, unsigned char* Pd, int t, int s, int cc) {
    float a[8];
#pragma unroll
    for (int q = 0; q < 8; ++q) a[q] = 0.f;
#pragma unroll
    for (int j = 0; j < W; ++j) { const float wgt = (s - j) >= 0 ? 1.f : 0.f;
#pragma unroll
        for (int q = 0; q < 4; ++q) { a[2 * q] += wgt * __uint_as_float(p.v[j][q] << 16); a[2 * q + 1] += wgt * __uint_as_float(p.v[j][q] & 0xffff0000u); } }
    const int cnt = (s + 1) < W ? (s + 1) : W; const float inv = 1.0f / (float)cnt; u32x4 o;
#pragma unroll
    for (int q = 0; q < 4; ++q) o[q] = cvt_pk_bf16(a[2 * q] * inv - __uint_as_float(p.v[0][q] << 16), a[2 * q + 1] * inv - __uint_as_float(p.v[0][q] & 0xffff0000u));
    *(u32x4*)(Pd + (size_t)t * LDM + cc * 16) = o;
}
__device__ __forceinline__ void p2_pooled(const Frame& F) {
    const int lane = lane_();
    const bf16_t* U = (const bf16_t*)(F.ws + WS_U); unsigned char* Pd = F.ws + WS_YCAT;
    for (int tp = F.vcu * 8 + F.wave; tp < NTOK / 2; tp += F.G * 8) {
        const int t = 2 * tp + (lane >> 5), s = t & (SEQ - 1), c5 = lane & 31;
        PoolV<2> p0; PoolV<4> p1; PoolV<8> p2; PoolV<16> p3;
        pooled_load<2>(p0, U, t, s, c5); pooled_load<4>(p1, U, t, s, 32 + c5); pooled_load<8>(p2, U, t, s, 64 + c5); pooled_load<16>(p3, U, t, s, 96 + c5);
        pooled_finish<2>(p0, Pd, t, s, c5); pooled_finish<4>(p1, Pd, t, s, 32 + c5); pooled_finish<8>(p2, Pd, t, s, 64 + c5); pooled_finish<16>(p3, Pd, t, s, 96 + c5);
    }
}
typedef float f32x2_t __attribute__((ext_vector_type(2)));
typedef __bf16 bf16x2_t __attribute__((ext_vector_type(2)));
__device__ __forceinline__ unsigned cvtpk_c(float lo, float hi) { const f32x2_t v = {lo, hi}; const bf16x2_t b = __builtin_convertvector(v, bf16x2_t); return __builtin_bit_cast(unsigned, b); }
#define MFMA32(a, b, c) __builtin_amdgcn_mfma_f32_32x32x16_bf16((a), (b), (c), 0, 0, 0)
__device__ __forceinline__ bf16x8 pack_lo8(const f32x16& x) { u32x4 p; p.x = cvt_pk_bf16(x[0], x[1]); p.y = cvt_pk_bf16(x[2], x[3]); p.z = cvt_pk_bf16(x[4], x[5]); p.w = cvt_pk_bf16(x[6], x[7]); return __builtin_bit_cast(bf16x8, p); }
__device__ __forceinline__ bf16x8 pack_hi8(const f32x16& x) { u32x4 p; p.x = cvt_pk_bf16(x[8], x[9]); p.y = cvt_pk_bf16(x[10], x[11]); p.z = cvt_pk_bf16(x[12], x[13]); p.w = cvt_pk_bf16(x[14], x[15]); return __builtin_bit_cast(bf16x8, p); }
__device__ __forceinline__ void p2_attention(const Frame& F, const float* rel_bias) {
    const unsigned char* Q8 = F.ws + WS_Q; const unsigned char* K8 = F.ws + WS_K; const bf16_t* Vg = (const bf16_t*)(F.ws + WS_V); unsigned char* Yc = F.ws + WS_YCAT;
    LAS unsigned char* lds = F.lds; LAS float* btab = (LAS float*)(lds + 98304);
    const int tid = tid_(), lane = tid & 63, wid = F.wave, l31 = lane & 31, h = lane >> 5;
    const unsigned ka0 = (unsigned)(l31 * 128 + (((2 * h) ^ ((l31 >> 1) & 7)) << 4)), ka1 = (unsigned)(l31 * 128 + (((2 * h + 1) ^ ((l31 >> 1) & 7)) << 4));
    unsigned vb[2];
    { const int blk = (lane >> 4) & 1, q = (lane & 15) >> 2, p = lane & 3;
#pragma unroll
      for (int t = 0; t < 2; ++t) vb[t] = (unsigned)(64 * (4 * h + q) + 8 * (p & 1) + 16 * ((2 * blk + (p >> 1)) ^ (h + 2 * t)) + 2048 * t); }
    unsigned ksrc, vsrc[2];
    { const int p = wid * 64 + lane, row = p >> 3, ch = (p & 7) ^ ((row >> 1) & 7); ksrc = (unsigned)(row * AW + ch * 16); }
#pragma unroll
    for (int i = 0; i < 2; ++i) { const int p = i * 512 + wid * 64 + lane;
        { const int rb = p >> 7, cq = (p & 127) >> 5, r7 = (p & 31) >> 2, x = p & 3, row = rb * 8 + r7, ch = cq * 4 + (x ^ ((row >> 2) & 3)); vsrc[i] = (unsigned)(row * (AW * 2) + ch * 16); } }
    for (int unit = F.vcu; unit < NTOK / 256 * NH; unit += F.G) {
        const int bh = unit >> 4, qb = (unit + bh) & 15, hd = bh % NH, b = bh / NH;
        const int tb = b * SEQ, c0 = 4 * qb, c = c0 + (wid >> 1), qrow = c * 64 + (wid & 1) * 32 + l31;
        const int kc_lo = (c0 - 8) > 0 ? (c0 - 8) : 0, kc_hi = c0 + 3;
        __syncthreads();
        if (tid < 320) btab[tid] = (rel_bias[hd * NREL + (tid < NREL - 1 ? tid : NREL - 1)] - rel_bias[hd * NREL + NREL - 1]) * LOG2E;
        i32x8 qf[2];
        { const unsigned char* qp = Q8 + (size_t)(tb + qrow) * AW + hd * HD + 32 * h;
#pragma unroll
          for (int j = 0; j < 2; ++j) { const i32x4 lo = *(const i32x4*)(qp + 64 * j), hi = *(const i32x4*)(qp + 64 * j + 16); qf[j] = __builtin_shufflevector(lo, hi, 0, 1, 2, 3, 4, 5, 6, 7); } }
#define ATT_ISSUE(kc, buf) do { const char* kg_ = (const char*)K8 + ((size_t)(tb + (kc) * 64) * AW + hd * HD); const char* vg_ = (const char*)Vg + ((size_t)(tb + (kc) * 64) * AW + hd * HD) * 2; \
        __builtin_amdgcn_global_load_lds((const unsigned*)(kg_ + ksrc), (LAS unsigned*)(lds + (buf) * 32768 + wid * 1024), 16, 0, 0);     \
        _Pragma("unroll") for (int i_ = 0; i_ < 2; ++i_) { \
            __builtin_amdgcn_global_load_lds((const unsigned*)(vg_ + vsrc[i_]), (LAS unsigned*)(lds + (buf) * 32768 + 16384 + i_ * 8192 + wid * 1024), 16, 0, 0); } } while (0)
        ATT_ISSUE(kc_lo, 0);
        if (kc_lo < kc_hi) ATT_ISSUE(kc_lo + 1, 1);
        float mrun = 0.f, lsum = 0.f; f32x16 O[4];
#pragma unroll
        for (int d = 0; d < 4; ++d)
#pragma unroll
            for (int r = 0; r < 16; ++r) O[d][r] = 0.f;
        int buf = 0;
        for (int kc = kc_lo; kc <= kc_hi; ++kc) {
            if (kc < kc_hi) asm volatile("s_waitcnt vmcnt(3)" ::: "memory"); else asm volatile("s_waitcnt vmcnt(0)" ::: "memory");
            __syncthreads();
            if (kc + 2 <= kc_hi) ATT_ISSUE(kc + 2, (buf >= 1 ? buf - 1 : 2));
            if (kc >= c - 8 && kc <= c) {
                const LAS unsigned char* Kb = lds + buf * 32768; const LAS unsigned char* Vb = lds + buf * 32768 + 16384;
#define ATT_KF(hk, j) __builtin_shufflevector(*(const LAS i32x4*)(Kb + (hk) * 4096 + (ka0 ^ (64u * (j)))), *(const LAS i32x4*)(Kb + (hk) * 4096 + (ka1 ^ (64u * (j)))), 0, 1, 2, 3, 4, 5, 6, 7)
#define ATT_QK(S, kf, j) S = __builtin_amdgcn_mfma_scale_f32_32x32x64_f8f6f4((kf), qf[j], S, 0, 0, 0, 0x7C7C7C7C, 0, 0x7A7A7A7A)
                f32x16 S0, S1; i32x8 kf0[2], kf1[2];
                kf0[0] = ATT_KF(0, 0); kf0[1] = ATT_KF(0, 1);
                if (kc > c - 3) { const LAS float* bp = btab + (qrow - kc * 64 - 4 * h + (128 - 59));
#pragma unroll
                    for (int r = 0; r < 16; ++r) { const int ko = (r & 3) + 8 * (r >> 2); S0[r] = bp[59 - ko] - mrun; S1[r] = bp[27 - ko] - mrun; }
                } else {
#pragma unroll
                    for (int r = 0; r < 16; ++r) { S0[r] = -mrun; S1[r] = -mrun; }
                }
                __builtin_amdgcn_sched_barrier(0);
                kf1[0] = ATT_KF(1, 0); kf1[1] = ATT_KF(1, 1);
                __builtin_amdgcn_sched_barrier(0);
                ATT_QK(S0, kf0[0], 0); ATT_QK(S0, kf0[1], 1);
                __builtin_amdgcn_sched_barrier(0);
                const unsigned va0 = (unsigned)(size_t)(Vb + vb[0]), va1 = (unsigned)(size_t)(Vb + vb[1]);
                s16x4 vr[4][8];
#define ATT_VREAD(dst, sp) asm volatile("ds_read_b64_tr_b16 %0, %8 offset:%10\n\tds_read_b64_tr_b16 %1, %9 offset:%10\n\tds_read_b64_tr_b16 %2, %8 offset:%11\n\tds_read_b64_tr_b16 %3, %9 offset:%11\n\t" \
                                               "ds_read_b64_tr_b16 %4, %8 offset:%12\n\tds_read_b64_tr_b16 %5, %9 offset:%12\n\tds_read_b64_tr_b16 %6, %8 offset:%13\n\tds_read_b64_tr_b16 %7, %9 offset:%13" \
                    : "=&v"(dst[0]), "=&v"(dst[1]), "=&v"(dst[2]), "=&v"(dst[3]), "=&v"(dst[4]), "=&v"(dst[5]), "=&v"(dst[6]), "=&v"(dst[7]) \
                    : "v"(va0), "v"(va1), "n"(4096 * (sp)), "n"(4096 * (sp) + 512), "n"(4096 * (sp) + 1024), "n"(4096 * (sp) + 1536) : "memory")
#define ATT_VWAIT(dst, n) asm volatile("s_waitcnt lgkmcnt(" #n ")" : "+v"(dst[0]), "+v"(dst[1]), "+v"(dst[2]), "+v"(dst[3]), "+v"(dst[4]), "+v"(dst[5]), "+v"(dst[6]), "+v"(dst[7]) :: "memory")
                ATT_VREAD(vr[0], 0); ATT_VREAD(vr[1], 1);
                __builtin_amdgcn_sched_barrier(0);
                float ps = 0.f; unsigned pk0[8], pk1[8];
#define ATT_SM(S, pk, i) do { const float e0_ = __builtin_amdgcn_exp2f(S[2 * (i)]), e1_ = __builtin_amdgcn_exp2f(S[2 * (i) + 1]); ps += e0_; ps += e1_; pk[i] = cvtpk_c(e0_, e1_); } while (0)
#define ATT_PVM(sp, d, pf) do { const bf16x8 vf_ = __builtin_shufflevector(vr[sp][2 * (d)], vr[sp][2 * (d) + 1], 0, 1, 2, 3, 4, 5, 6, 7); O[d] = MFMA32(vf_, pf, O[d]); } while (0)
                ATT_QK(S1, kf1[0], 0);
                __builtin_amdgcn_sched_barrier(0);
                ATT_QK(S1, kf1[1], 1); ATT_SM(S0, pk0, 0); ATT_SM(S0, pk0, 1); ATT_SM(S0, pk0, 2); ATT_SM(S0, pk0, 3);
                __builtin_amdgcn_sched_barrier(0);
                ATT_SM(S0, pk0, 4); ATT_SM(S0, pk0, 5); ATT_SM(S0, pk0, 6);
                __builtin_amdgcn_sched_barrier(0);
                ATT_VWAIT(vr[0], 0); ATT_VWAIT(vr[1], 0);
                ATT_VREAD(vr[2], 2); ATT_VREAD(vr[3], 3);
                __builtin_amdgcn_sched_barrier(0);
                { const bf16x8 pf0 = __builtin_bit_cast(bf16x8, ((u32x4){pk0[0], pk0[1], pk0[2], pk0[3]}));
                  ATT_PVM(0, 0, pf0); ATT_SM(S0, pk0, 7); __builtin_amdgcn_sched_barrier(0);
                  ATT_PVM(0, 1, pf0); __builtin_amdgcn_sched_barrier(0);
                  ATT_PVM(0, 2, pf0); ATT_SM(S1, pk1, 0); __builtin_amdgcn_sched_barrier(0);
                  ATT_PVM(0, 3, pf0); ATT_SM(S1, pk1, 1); __builtin_amdgcn_sched_barrier(0); }
                { const bf16x8 pf1 = __builtin_bit_cast(bf16x8, ((u32x4){pk0[4], pk0[5], pk0[6], pk0[7]}));
                  ATT_PVM(1, 0, pf1); ATT_SM(S1, pk1, 2); __builtin_amdgcn_sched_barrier(0);
                  ATT_PVM(1, 1, pf1); ATT_SM(S1, pk1, 3); __builtin_amdgcn_sched_barrier(0);
                  ATT_PVM(1, 2, pf1); ATT_SM(S1, pk1, 4); __builtin_amdgcn_sched_barrier(0);
                  ATT_PVM(1, 3, pf1); ATT_SM(S1, pk1, 5); __builtin_amdgcn_sched_barrier(0); }
                ATT_VWAIT(vr[2], 0); ATT_VWAIT(vr[3], 0);
                { const bf16x8 pf2 = __builtin_bit_cast(bf16x8, ((u32x4){pk1[0], pk1[1], pk1[2], pk1[3]}));
                  ATT_PVM(2, 0, pf2); ATT_SM(S1, pk1, 6); __builtin_amdgcn_sched_barrier(0);
                  ATT_PVM(2, 1, pf2); ATT_SM(S1, pk1, 7); __builtin_amdgcn_sched_barrier(0);
                  ATT_PVM(2, 2, pf2); ATT_PVM(2, 3, pf2); }
                { const bf16x8 pf3 = __builtin_bit_cast(bf16x8, ((u32x4){pk1[4], pk1[5], pk1[6], pk1[7]}));
                  ATT_PVM(3, 0, pf3); ATT_PVM(3, 1, pf3); ATT_PVM(3, 2, pf3); ATT_PVM(3, 3, pf3); }
#undef ATT_SM
#undef ATT_KF
#undef ATT_QK
#undef ATT_PVM
                lsum += ps;
                if (__any(ps > 65536.0f)) {
                    const float pm = fmaxf(ps, __shfl_xor(ps, 32)); const float dl = pm > 256.0f ? floorf(__builtin_amdgcn_logf(pm)) : 0.f, alpha = __builtin_amdgcn_exp2f(-dl); mrun += dl; lsum *= alpha;
#pragma unroll
                    for (int d = 0; d < 4; ++d)
#pragma unroll
                        for (int r = 0; r < 16; ++r) O[d][r] *= alpha;
                }
#undef ATT_VREAD
#undef ATT_VWAIT
            }
            buf = (buf == 2) ? 0 : buf + 1;
        }
#undef ATT_ISSUE
        lsum += __shfl_xor(lsum, 32);
        const float inv = 1.0f / lsum;
        const float inv64 = inv * YA_SCALE;
        unsigned char* yp = Yc + (size_t)(tb + qrow) * LDM + 2048 + hd * HD + 4 * h;
#pragma unroll
        for (int d = 0; d < 4; ++d)
#pragma unroll
            for (int g = 0; g < 4; ++g) *(unsigned*)(yp + 32 * d + 8 * g) = pk4_fp8(O[d][4 * g] * inv64, O[d][4 * g + 1] * inv64, O[d][4 * g + 2] * inv64, O[d][4 * g + 3] * inv64);
    }
}

__device__ __forceinline__ void p6_route_scatter(const Frame& F, const Params& P) {
    const int lane = lane_(), tid = F.wave * 64 + lane;
    const float* lg = (const float*)(F.ws + WS_LOG); const float* ssq = (const float*)(F.ws + WS_SSQ);
    unsigned* tm = (unsigned*)(F.ws + WS_TOK); float* rm = (float*)(F.ws + WS_ROW); const bf16_t* xg = (const bf16_t*)(F.ws + WS_H); unsigned char* Xs = F.ws + WS_XS;
    unsigned* gcnt = F.ctl + CW_CNT;
    LAS unsigned* lcnt = (LAS unsigned*)(F.lds + LDS_TAB); LAS unsigned* lbase = lcnt + 32; LAS unsigned* dpair = lcnt + 64; LAS float* rsl = (LAS float*)(lcnt + 192);
    const float* brg = P.in[11]; const float* bre = P.in[13];
    for (int tb = F.vcu; tb < NTOK / 64; tb += F.G) {
        __syncthreads();
        if (tid < 32) lcnt[tid] = 0u;
        __syncthreads();
        int e1 = 0, e2 = 0; unsigned p1 = 0, p2 = 0; float g1 = 0.f, g2 = 0.f, rstd = 0.f; const int t = tb * 64 + tid;
        if (tid < 64) {
            float s = 0.f;
            for (int j = 0; j < 64; ++j) s += ssq[(size_t)t * 64 + j];
            rstd = 1.0f / sqrtf(s * (1.0f / DM) + EPS);
            float l4[4]; int gi = 0;
#pragma unroll
            for (int j = 0; j < 4; ++j) l4[j] = ((lg[(size_t)t * 64 + j] + lg[(size_t)NTOK * 64 + (size_t)t * 64 + j]) + (lg[(size_t)2 * NTOK * 64 + (size_t)t * 64 + j] + lg[(size_t)3 * NTOK * 64 + (size_t)t * 64 + j])) * rstd + brg[j];
#pragma unroll
            for (int j = 1; j < 4; ++j) if (l4[j] > l4[gi]) gi = j;
            float den = 0.f;
#pragma unroll
            for (int j = 0; j < 4; ++j) den += expf(l4[j] - l4[gi]);
            const float psel = 1.0f / den;
            float le[8]; int i1 = 0;
            for (int j = 0; j < 8; ++j) { const size_t o = (size_t)t * 64 + 4 + gi * 8 + j; le[j] = ((lg[o] + lg[(size_t)NTOK * 64 + o]) + (lg[(size_t)2 * NTOK * 64 + o] + lg[(size_t)3 * NTOK * 64 + o])) * rstd + bre[gi * 8 + j]; }
            for (int j = 1; j < 8; ++j) if (le[j] > le[i1]) i1 = j;
            int i2 = (i1 == 0) ? 1 : 0;
            for (int j = 0; j < 8; ++j) if (j != i1 && le[j] > le[i2]) i2 = j;
            const float w2 = 1.0f / (1.0f + expf(le[i1] - le[i2])), w1 = 1.0f - w2;
            g1 = psel * w1; g2 = psel * w2; e1 = gi * 8 + i1; e2 = gi * 8 + i2;
            p1 = atomicAdd((unsigned*)&lcnt[e1], 1u); p2 = atomicAdd((unsigned*)&lcnt[e2], 1u);
        }
        __syncthreads();
        if (tid < 32) { const unsigned n = lcnt[tid]; lbase[tid] = n ? __hip_atomic_fetch_add(gcnt + tid, n, __ATOMIC_RELAXED, __HIP_MEMORY_SCOPE_AGENT) : 0u; }
        __syncthreads();
        if (tid < 64) {
            unsigned s1 = lbase[e1] + p1, s2 = lbase[e2] + p2; s1 = s1 < (unsigned)ECAP ? s1 : (unsigned)ECAP - 1u; s2 = s2 < (unsigned)ECAP ? s2 : (unsigned)ECAP - 1u;
            const unsigned d1 = (unsigned)e1 * ECAP + s1, d2 = (unsigned)e2 * ECAP + s2;
            tm[TM_DEST + 2 * t] = d1; tm[TM_DEST + 2 * t + 1] = d2; dpair[2 * tid] = d1; dpair[2 * tid + 1] = d2;
            rm[RM_GATE + d1] = g1; rm[RM_GATE + d2] = g2; rsl[tid] = rstd;
        }
        __syncthreads();
#pragma unroll 2
        for (int i = 0; i < 8; ++i) { const int tl = F.wave * 8 + i, tt = tb * 64 + tl; const unsigned d0 = dpair[2 * tl], d1 = dpair[2 * tl + 1]; const float rs = rsl[tl];
            const u32x4* sp = (const u32x4*)(xg + (size_t)tt * LDK) + lane; u32x4 v[8];
#pragma unroll
            for (int j = 0; j < 8; ++j) v[j] = sp[64 * j];
            u32x2* o0 = (u32x2*)(Xs + (size_t)d0 * LDK8) + lane; u32x2* o1 = (u32x2*)(Xs + (size_t)d1 * LDK8) + lane;
#pragma unroll
            for (int j = 0; j < 8; ++j) { const u32x2 f8 = bf16x8_to_fp8(v[j], rs); o0[64 * j] = f8; o1[64 * j] = f8; } }
    }
}
__device__ __forceinline__ int build_tiles(const Frame& F) {
    const int tid = tid_();
    LAS int* ptile = (LAS int*)(F.lds + LDS_TAB + 512); LAS int* tile_e = (LAS int*)(F.lds + LDS_TAB + 1024);
    const unsigned* gcnt = F.ctl + CW_CNT;
    __syncthreads();
    if (tid == 0) { int accu = 0;
        for (int e = 0; e < NE; ++e) { const unsigned c = gcnt[e] < (unsigned)ECAP ? gcnt[e] : (unsigned)ECAP; const int nt = (int)((c + 255u) >> 8); for (int k = 0; k < nt; ++k) tile_e[accu + k] = e * 8 + k; accu += nt; }
        ptile[0] = accu; }
    __syncthreads();
    return __builtin_amdgcn_readfirstlane(ptile[0]);
}
__device__ __forceinline__ void p10_combine(const Frame& F, float* out) {
    const int lane = lane_();
    const unsigned* tm = (const unsigned*)(F.ws + WS_TOK); const unsigned char* Y = F.ws + WS_Y; const bf16_t* x1b = (const bf16_t*)(F.ws + WS_H);
    int t = F.vcu * 8 + F.wave; unsigned d0 = tm[TM_DEST + 2 * t], d1 = tm[TM_DEST + 2 * t + 1];
    for (; t < NTOK; t += F.G * 8) { const int tn = t + F.G * 8; unsigned nd0 = d0, nd1 = d1; if (tn < NTOK) { nd0 = tm[TM_DEST + 2 * tn]; nd1 = tm[TM_DEST + 2 * tn + 1]; }
        const u32x2* y0 = (const u32x2*)(Y + (size_t)d0 * DM) + lane; const u32x2* y1 = (const u32x2*)(Y + (size_t)d1 * DM) + lane; const u32x4* xs = (const u32x4*)(x1b + (size_t)t * LDK) + lane;
        f32x4* o = (f32x4*)(out + (size_t)t * DM) + 2 * lane;
        u32x2 a[8], b[8]; u32x4 xv[8];
#pragma unroll
        for (int j = 0; j < 8; ++j) xv[j] = xs[64 * j];
#pragma unroll
        for (int j = 0; j < 8; ++j) { a[j] = y0[64 * j]; b[j] = y1[64 * j]; }
#pragma unroll
        for (int j = 0; j < 8; ++j) { f32x4 v0, v1;
            v0[0] = __uint_as_float(xv[j][0] << 16) + (__builtin_amdgcn_cvt_f32_fp8((int)a[j][0], 0) + __builtin_amdgcn_cvt_f32_fp8((int)b[j][0], 0)) * (1.0f / Y_SCALE);
            v0[1] = __uint_as_float(xv[j][0] & 0xffff0000u) + (__builtin_amdgcn_cvt_f32_fp8((int)a[j][0], 1) + __builtin_amdgcn_cvt_f32_fp8((int)b[j][0], 1)) * (1.0f / Y_SCALE);
            v0[2] = __uint_as_float(xv[j][1] << 16) + (__builtin_amdgcn_cvt_f32_fp8((int)a[j][0], 2) + __builtin_amdgcn_cvt_f32_fp8((int)b[j][0], 2)) * (1.0f / Y_SCALE);
            v0[3] = __uint_as_float(xv[j][1] & 0xffff0000u) + (__builtin_amdgcn_cvt_f32_fp8((int)a[j][0], 3) + __builtin_amdgcn_cvt_f32_fp8((int)b[j][0], 3)) * (1.0f / Y_SCALE);
            v1[0] = __uint_as_float(xv[j][2] << 16) + (__builtin_amdgcn_cvt_f32_fp8((int)a[j][1], 0) + __builtin_amdgcn_cvt_f32_fp8((int)b[j][1], 0)) * (1.0f / Y_SCALE);
            v1[1] = __uint_as_float(xv[j][2] & 0xffff0000u) + (__builtin_amdgcn_cvt_f32_fp8((int)a[j][1], 1) + __builtin_amdgcn_cvt_f32_fp8((int)b[j][1], 1)) * (1.0f / Y_SCALE);
            v1[2] = __uint_as_float(xv[j][3] << 16) + (__builtin_amdgcn_cvt_f32_fp8((int)a[j][1], 2) + __builtin_amdgcn_cvt_f32_fp8((int)b[j][1], 2)) * (1.0f / Y_SCALE);
            v1[3] = __uint_as_float(xv[j][3] & 0xffff0000u) + (__builtin_amdgcn_cvt_f32_fp8((int)a[j][1], 3) + __builtin_amdgcn_cvt_f32_fp8((int)b[j][1], 3)) * (1.0f / Y_SCALE);
            o[128 * j] = v0; o[128 * j + 1] = v1; }
        d0 = nd0; d1 = nd1; }
}

__global__ void __launch_bounds__(512, 2) mk_fwd(Params P) {
    extern __shared__ __attribute__((aligned(16))) unsigned char lds_raw[];
    Frame F; F.lds = (LAS unsigned char*)lds_raw; F.wave = __builtin_amdgcn_readfirstlane((int)threadIdx.x >> 6);
    F.G = gridDim.x; F.bx = blockIdx.x; F.vcu = (F.G % 8 == 0) ? (F.bx % 8) * (F.G / 8) + F.bx / 8 : F.bx;
    F.ws = P.ws; F.ctl = (unsigned*)(P.ws + WS_CTL);
    volatile LAS unsigned* misc = (volatile LAS unsigned*)(F.lds + LDS_MISC);
    { const int t0 = tid_(); if (t0 < 4) misc[t0] = 0u; }
    __syncthreads();
    XcdBarrier bar; bar.bar = F.ctl + CW_BAR; bar.x = 0; bar.st = misc;
    const int lo = P.ph_lo, hi = P.ph_hi;
    if (hi - lo > 1) bar = xcd_barrier_post(F.ctl + CW_BAR, misc, tid_() == 0);
#define IN(k) (lo <= (k) && (k) < hi)
#define SEAM(k) do { if (IN(k) && IN((k) + 1)) xcd_barrier(bar, tid_() == 0); } while (0)
    LAS unsigned char* stage = F.lds + LDS_STAGE;
    bf16_t* Hb = (bf16_t*)(F.ws + WS_H);

    if (IN(0)) { p0_prologue(F, P); } SEAM(0);
    if (IN(1)) {
        {
            pg8::Shape g{256 / 64, PW * 2, 256 * 2}; pg8::PoolOrder S{(const char*)(F.ws + WS_POOLED), (const char*)(F.ws + WS_GW), F.G, F.bx, 64};
            EpiPool E{F.ws + WS_WOUT, nullptr};
            pg8::gemm_phase<-1, 0x7F7F7F7F, 0x7F7F7F7F>(stage, F.wave, g, S, E); }
        EpiProj E{(bf16_t*)(F.ws + WS_U), (bf16_t*)(F.ws + WS_Q), (bf16_t*)(F.ws + WS_K), (bf16_t*)(F.ws + WS_V), P.in[5], P.in[6], (LAS float*)(F.lds + LDS_XCH), P.flags & 1, 0};
        { pg8::Shape g{DM / 64, LDK * 2, LDK * 2}; pg8::DenseOrder S; S.init(Hb, F.ws + WS_WINU, LDK * 2, LDK * 2, NTOK, PW, F.G, F.bx);
          pg8::gemm_phase<-1, 0x7F7F7F7F, 0x7F7F7F7F>(stage, F.wave, g, S, E); }
        E.pn0 = 4;
        { pg8::Shape g{DM / 128, LDK8, LDK8}; pg8::DenseOrder S; S.init(F.ws + WS_H8, F.ws + WS_WIN8, LDK8, LDK8, NTOK, 3 * AW, F.G, F.bx);
          pg8::gemm_phase<0, 0x77777777, 0x7F7F7F7F>(stage, F.wave, g, S, E); }
    } SEAM(1);
    if (IN(2)) { p2_pooled(F); p2_attention(F, P.in[7]); } SEAM(2);
    if (IN(4)) {
        pg8::Shape g{16 + 24, LDM, LDM}; pg8::DenseOrder S; S.init(F.ws + WS_YCAT, F.ws + WS_WOUT, LDM, LDM, NTOK, DM, F.G, F.bx);
        EpiOut E{P.in[1], (const float*)(F.ws + WS_TOK) + TM_RSTD, Hb, (float*)(F.ws + WS_SSQ), P.flags & 1};
        pg8::gemm_phase<16, 0x77777777, 0x79797979>(stage, F.wave, g, S, E);
    } SEAM(4);
    if (IN(5)) {
        pg8::Shape g{1024 / 64, LDK * 2, LDK * 2}; pg8::RouterOrder S{(const char*)Hb, (const char*)(F.ws + WS_WR), F.G, F.bx};
        EpiLogits E{(float*)(F.ws + WS_LOG)};
        pg8::gemm_phase<-1, 0x7F7F7F7F, 0x7F7F7F7F>(stage, F.wave, g, S, E);
    } SEAM(5);
    if (IN(6)) { p6_route_scatter(F, P); }
    if (IN(6) && IN(8)) xcd_barrier(bar, tid_() == 0);
    if (IN(8)) {
        const int NT = build_tiles(F);
        pg8::Shape g{DM / 128, LDK8, LDK8};
        pg8::GroupedOrder S{(const char*)(F.ws + WS_XS), (const char*)(F.ws + WS_WGU), LDK8, LDK8, NT, 8, 2048, F.G, F.bx, (const LAS int*)(F.lds + LDS_TAB + 1024)};
        EpiSwiglu E{F.ws + WS_ABUF, (const float*)(F.ws + WS_ROW) + RM_GATE, F.ctl + CW_PAN, F.ctl + CW_P8DONE};
        pg8::gemm_phase<0, 0x77777777, 0x7F7F7F7F>(stage, F.wave, g, S, E);
    }
#if MK_LAUNCHES != 1
    SEAM(8);
#endif
    if (IN(9)) {
        const int NT = build_tiles(F);
        pg8::Shape g{DE / 128, LDE8, LDE8};
        volatile LAS unsigned* fl = (volatile LAS unsigned*)(F.lds + LDS_MISC + 64); if (tid_() == 0) fl[0] = 0u;
        __syncthreads();
        pg8::DownOrder S{(const char*)(F.ws + WS_ABUF), (const char*)(F.ws + WS_WD), LDE8, LDE8, NT, F.G, F.bx, F.wave, (const LAS int*)(F.lds + LDS_TAB + 1024), F.ctl + CW_PAN, F.ctl + CW_P8DONE, fl};
        EpiDown E{F.ws + WS_Y};
        pg8::gemm_phase<0, 0x78787878, -2139062144  , EpiDown, pg8::DownOrder, true>(stage, F.wave, g, S, E);
    } SEAM(9);
    if (IN(10)) { p10_combine(F, P.out); }
#if defined(MK_BURN)
    if (IN(11)) {
        f32x4 c0 = {0.f, 0.f, 0.f, 0.f}, c1 = c0, c2 = c0, c3 = c0; bf16x8 a, b;
        for (int j = 0; j < 8; ++j) { a[j] = (short)(0x3c00 + tid_()); b[j] = (short)(0x3c01 + j); }
#pragma unroll 1
        for (int it = 0; it < 65536 / 8; ++it) {
            c0 = __builtin_amdgcn_mfma_f32_16x16x32_bf16(a, b, c0, 0, 0, 0); c1 = __builtin_amdgcn_mfma_f32_16x16x32_bf16(a, b, c1, 0, 0, 0);
            c2 = __builtin_amdgcn_mfma_f32_16x16x32_bf16(a, b, c2, 0, 0, 0); c3 = __builtin_amdgcn_mfma_f32_16x16x32_bf16(a, b, c3, 0, 0, 0);
            c0 = __builtin_amdgcn_mfma_f32_16x16x32_bf16(a, b, c0, 0, 0, 0); c1 = __builtin_amdgcn_mfma_f32_16x16x32_bf16(a, b, c1, 0, 0, 0);
            c2 = __builtin_amdgcn_mfma_f32_16x16x32_bf16(a, b, c2, 0, 0, 0); c3 = __builtin_amdgcn_mfma_f32_16x16x32_bf16(a, b, c3, 0, 0, 0); }
        const f32x4 r = c0 + c1 + c2 + c3; if (r[0] + r[1] + r[2] + r[3] == 1.2345f) F.ctl[200000] = 1u;
    }
#endif
#undef IN
#undef SEAM
}

#ifdef MK_DBG
__global__ void dbg_dump(const bf16_t* b0, int ld0, const bf16_t* b1, int ld1, const bf16_t* b2, int ld2, const bf16_t* b3, int ld3, float* out) {
    for (size_t i = (size_t)blockIdx.x * blockDim.x + threadIdx.x; i < (size_t)NTOK * DM; i += (size_t)gridDim.x * blockDim.x) {
        const int t = (int)(i >> 12), c = (int)(i & 4095), q = c >> 10, cc = c & 1023;
        const bf16_t* b = q == 0 ? b0 : q == 1 ? b1 : q == 2 ? b2 : b3; const int ld = q == 0 ? ld0 : q == 1 ? ld1 : q == 2 ? ld2 : ld3;
        out[i] = bf2f(b[(size_t)t * ld + cc]); }
}
#endif
extern "C" void kernel_launch(void* const* d_in, const int* in_sizes, int n_in, void* d_out, int out_size, void* d_ws, size_t ws_size, hipStream_t stream) {
    static int grid = 0;
    if (grid == 0) {
        if (n_in != 17 || out_size != NTOK * DM || ws_size < WS_END) { fprintf(stderr, "kernel_launch: unexpected shapes (n_in %d, out %d, ws %zu < %zu)\n", n_in, out_size, ws_size, (size_t)WS_END); grid = -1; return; }
        int dev = 0, cus = 0, per_cu = 0;
        if (hipGetDevice(&dev) != hipSuccess || hipDeviceGetAttribute(&cus, hipDeviceAttributeMultiprocessorCount, dev) != hipSuccess) { grid = -1; return; }
        if (hipFuncSetAttribute((const void*)mk_fwd, hipFuncAttributeMaxDynamicSharedMemorySize, LDS_BYTES) != hipSuccess) { fprintf(stderr, "kernel_launch: hipFuncSetAttribute failed\n"); grid = -1; return; }
        if (hipOccupancyMaxActiveBlocksPerMultiprocessor(&per_cu, (const void*)mk_fwd, 512, LDS_BYTES) != hipSuccess || per_cu < 1) { fprintf(stderr, "kernel_launch: occupancy query says %d\n", per_cu); }
        (void)hipGetLastError();
        grid = cus;
    }
    if (grid < 0) return;
    (void)hipMemsetAsync((char*)d_ws + WS_CTL, 0, CTL_BYTES, stream);
    Params p{};
    for (int i = 0; i < 17; ++i) p.in[i] = (const float*)d_in[i];
    p.out = (float*)d_out; p.ws = (unsigned char*)d_ws;
#if MK_LAUNCHES == 1
    p.ph_lo = 0; p.ph_hi = NPH < MK_STOP ? NPH : MK_STOP;
    hipLaunchKernelGGL(mk_fwd, dim3(grid), dim3(512), LDS_BYTES, stream, p);
#else
    for (int ph = 0; ph < NPH && ph < MK_STOP; ++ph) { p.ph_lo = ph; p.ph_hi = ph + 1; hipLaunchKernelGGL(mk_fwd, dim3(grid), dim3(512), LDS_BYTES, stream, p);
#if defined(MK_BURN)
        if (ph == 4) { p.ph_lo = 11; p.ph_hi = 12; hipLaunchKernelGGL(mk_fwd, dim3(grid), dim3(512), LDS_BYTES, stream, p); }
#endif
        if (ph == MK_REPEAT) { p.flags = MK_REPEAT_FLAGS; hipLaunchKernelGGL(mk_fwd, dim3(grid), dim3(512), LDS_BYTES, stream, p); p.flags = 0; } }
#endif
#ifdef MK_DBG
    { unsigned char* w = (unsigned char*)d_ws;
#if MK_DBG == 1
      hipLaunchKernelGGL(dbg_dump, dim3(2048), dim3(256), 0, stream, (const bf16_t*)(w + WS_U), 1024, (const bf16_t*)(w + WS_Q), 3072, (const bf16_t*)(w + WS_K), 3072, (const bf16_t*)(w + WS_V), 3072, (float*)d_out);
#elif MK_DBG == 0
      hipLaunchKernelGGL(dbg_dump, dim3(2048), dim3(256), 0, stream, (const bf16_t*)(w + WS_H), 4096, (const bf16_t*)(w + WS_H) + 1024, 4096, (const bf16_t*)(w + WS_H) + 2048, 4096, (const bf16_t*)(w + WS_H) + 3072, 4096, (float*)d_out);
#elif MK_DBG == 2
      hipLaunchKernelGGL(dbg_dump, dim3(2048), dim3(256), 0, stream, (const bf16_t*)(w + WS_POOLED), 1024, (const bf16_t*)(w + WS_YCAT) + 1024, 4096, (const bf16_t*)(w + WS_YCAT) + 2048, 4096, (const bf16_t*)(w + WS_YCAT) + 3072, 4096, (float*)d_out);
#endif
    }
#endif
}
```

```cpp
#include <hip/hip_runtime.h>
#include <stdint.h>
#include <stdio.h>

#ifndef MK_LAUNCHES
#define MK_LAUNCHES 1
#endif

#ifndef MK_REPEAT
#define MK_REPEAT -1
#endif
#ifndef MK_REPEAT_FLAGS
#define MK_REPEAT_FLAGS 0
#endif
#ifndef MK_STOP
#define MK_STOP 11
#endif
#define LAS __attribute__((address_space(3)))
typedef unsigned short bf16_t;
typedef short bf16x8 __attribute__((ext_vector_type(8)));
typedef short s16x4 __attribute__((ext_vector_type(4)));
typedef float f32x4 __attribute__((ext_vector_type(4)));
typedef float f32x16 __attribute__((ext_vector_type(16)));
typedef unsigned u32x4 __attribute__((ext_vector_type(4)));
typedef unsigned u32x2 __attribute__((ext_vector_type(2)));
typedef int i32x4 __attribute__((ext_vector_type(4)));
typedef int i32x8 __attribute__((ext_vector_type(8)));

constexpr int NTOK = 16384, DM = 4096, SEQ = 4096, INW = 10240, PW = 1024, AW = 3072, NH = 24, HD = 128, NREL = 257;
constexpr int NE = 32, DE = 1024, ECAP = 1536, ETILES = ECAP / 256, MAXROWS = NE * ECAP, MAXTILES = NE * ETILES;
constexpr int LDK8 = DM + 128, LDE8 = DE + 128;
constexpr float Y_SCALE = 64.f;
constexpr float WGU_SCALE = 256.f, WD_SCALE = 128.f, A_SCALE = 32.f;
constexpr int LDM = 2048 + 3072 + 128;
constexpr float Q8_SCALE = 32.f, K8_SCALE = 8.f, V8_SCALE = 8.f;
constexpr float WIN_SCALE = 256.f, WOUT_SCALE = 256.f, YA_SCALE = 64.f;
constexpr int LDK = DM + 64, LDE = DE + 64;
constexpr float EPS = 1e-6f, LOG2E = 1.4426950408889634f;
constexpr float QSCALE = 0.08838834764831845f * 1.4426950408889634f;
constexpr int NPH = 11;

constexpr size_t MiB = 1u << 20;
constexpr size_t WS_CTL = 0, CTL_BYTES = 1 * MiB;
constexpr size_t WS_WINU = 1 * MiB;
constexpr size_t WS_WIN8 = WS_WINU + 9 * MiB;
constexpr size_t WS_WOUT = WS_WIN8 + 38 * MiB;
constexpr size_t WS_WGU = WS_WOUT + 21 * MiB;
constexpr size_t WS_WD = WS_WGU + 264 * MiB;
constexpr size_t WS_WR = WS_WD + 144 * MiB;
constexpr size_t WS_GW = WS_WR + 3 * MiB;
constexpr size_t WS_H = WS_GW + 1 * MiB;
constexpr size_t WS_H8 = WS_H + 130 * MiB;
constexpr size_t WS_U = WS_H8 + 67 * MiB;
constexpr size_t WS_Q = WS_U + 32 * MiB;
constexpr size_t WS_K = WS_Q + 96 * MiB;
constexpr size_t WS_V = WS_K + 96 * MiB;
constexpr size_t WS_POOLED = WS_V + 96 * MiB;
constexpr size_t WS_XS = WS_U;
constexpr size_t WS_YCAT = WS_POOLED + 32 * MiB;
constexpr size_t WS_ABUF = WS_YCAT;
constexpr size_t WS_LOG = WS_YCAT + 82 * MiB;
constexpr size_t WS_SSQ = WS_LOG + 16 * MiB;
constexpr size_t WS_TOK = WS_SSQ + 4 * MiB;
constexpr size_t WS_ROW = WS_TOK + 1 * MiB;
constexpr size_t WS_Y = WS_ROW + 1 * MiB;
constexpr size_t WS_END = WS_Y + 192 * MiB;
static_assert(WS_END <= 2048 * MiB, "workspace map");
constexpr int CW_BAR = 1024;
constexpr int CW_CNT = 8192;
constexpr int TM_E = 0, TM_POS = 2 * NTOK, TM_GATE = 4 * NTOK, TM_DEST = 6 * NTOK, TM_RSTD = 8 * NTOK;
constexpr int RM_GATE = 0, RM_RSTD = MAXROWS;

constexpr int LDS_STAGE = 0, STAGE_BYTES = 131072;
constexpr int LDS_XCH = 131072;
constexpr int LDS_TAB = LDS_XCH + 8192;
constexpr int LDS_MISC = LDS_TAB + 2048;
constexpr int LDS_BYTES = 147456;
static_assert(LDS_MISC + 256 <= LDS_BYTES, "lds map");

__device__ __forceinline__ unsigned cvt_pk_bf16(float lo, float hi) { unsigned r; asm volatile("v_cvt_pk_bf16_f32 %0, %1, %2" : "=v"(r) : "v"(lo), "v"(hi)); return r; }
__device__ __forceinline__ float clamp448(float v) { return fminf(fmaxf(v, -448.f), 448.f); }
__device__ __forceinline__ unsigned pk4_fp8(float a, float b, float c, float d) { int r = __builtin_amdgcn_cvt_pk_fp8_f32(clamp448(a), clamp448(b), 0, false); r = __builtin_amdgcn_cvt_pk_fp8_f32(clamp448(c), clamp448(d), r, true); return (unsigned)r; }
__device__ __forceinline__ u32x2 bf16x8_to_fp8(u32x4 v, float sc) { u32x2 o;
    o.x = pk4_fp8(__uint_as_float(v[0] << 16) * sc, __uint_as_float(v[0] & 0xffff0000u) * sc, __uint_as_float(v[1] << 16) * sc, __uint_as_float(v[1] & 0xffff0000u) * sc);
    o.y = pk4_fp8(__uint_as_float(v[2] << 16) * sc, __uint_as_float(v[2] & 0xffff0000u) * sc, __uint_as_float(v[3] << 16) * sc, __uint_as_float(v[3] & 0xffff0000u) * sc); return o; }
__device__ __forceinline__ float bf2f(unsigned short b) { return __uint_as_float(((unsigned)b) << 16); }
__device__ __forceinline__ float xor_lane(float v, int lane, int mask) { return __int_as_float(__builtin_amdgcn_ds_bpermute((lane ^ mask) << 2, __float_as_int(v))); }
__device__ __forceinline__ float wave_sum(float v) {
#pragma unroll
    for (int o = 1; o < 64; o <<= 1) v += __shfl_xor(v, o);
    return v;
}

__device__ __forceinline__ int lane_() { int l; asm volatile("v_mbcnt_lo_u32_b32 %0, -1, 0\n\tv_mbcnt_hi_u32_b32 %0, -1, %0" : "=v"(l)); return l; }
#define XB_TMO      128
#define XB_XCNT(j)  (256  + 64 * (j))
#define XB_XSUB(j)  (1280 + 64 * (j))
#define XB_XGEN(j)  (2304 + 64 * (j))
#define XB_TOP      3328
#define XB_TOPGEN   3392
#define XCD_BAR_WORDS 3456
#define XB_SPIN_CAP (1u << 18)
__device__ __forceinline__ unsigned xb_ld(unsigned* p)              { return __hip_atomic_load(p, __ATOMIC_RELAXED, __HIP_MEMORY_SCOPE_AGENT); }
__device__ __forceinline__ unsigned xb_add(unsigned* p, unsigned v) { return __hip_atomic_fetch_add(p, v, __ATOMIC_RELAXED, __HIP_MEMORY_SCOPE_AGENT); }
__device__ __forceinline__ unsigned xb_xcc_id() { return (unsigned)__builtin_amdgcn_s_getreg((3 << 11) | 20) & 0xFu; }
#define XB_SPIN(cond, bar) do { unsigned _sp = 0; while (cond) { __builtin_amdgcn_s_sleep(1); \
    if ((++_sp & 255u) == 0u) { if (xb_ld(&(bar)[XB_TMO])) break; if (_sp > XB_SPIN_CAP) { atomicAdd(&(bar)[XB_TMO], 1u); break; } } } } while (0)
struct XcdBarrier { unsigned* bar; unsigned x; volatile LAS unsigned* st; };
__device__ __forceinline__ XcdBarrier xcd_barrier_post(unsigned* bar, volatile LAS unsigned* st, bool leader) {
    XcdBarrier b; b.bar = bar; b.x = xb_xcc_id(); b.st = st;
    if (leader) (void)xb_add(&bar[XB_XCNT(b.x)], 1u);
    return b;
}
__device__ __forceinline__ void xcd_barrier_complete(unsigned* bar, unsigned x, unsigned& nloc, unsigned& nx) {
    const unsigned G = gridDim.x * gridDim.y * gridDim.z;
    unsigned sum, cnt, mine, sp = 0u;
    for (;;) {
        sum = 0u; cnt = 0u; mine = 0u;
#pragma unroll
        for (unsigned j = 0; j < 16; ++j) { const unsigned c = xb_ld(&bar[XB_XCNT(j)]); sum += c; cnt += (c > 0u) ? 1u : 0u; mine = (j == x) ? c : mine; }
        if (sum == G) break;
        __builtin_amdgcn_s_sleep(1);
        if ((++sp & 255u) == 0u) { if (xb_ld(&bar[XB_TMO])) break; if (sp > XB_SPIN_CAP) { atomicAdd(&bar[XB_TMO], 1u); break; } }
    }
    nloc = mine > 0u ? mine : 1u; nx = cnt > 0u ? cnt : 1u;
}
__device__ __forceinline__ void xcd_barrier(const XcdBarrier& b, bool leader) {
    asm volatile("s_waitcnt vmcnt(0)" ::: "memory");
    __syncthreads();
    if (leader) {
        unsigned* bar = b.bar;
        __builtin_amdgcn_s_waitcnt(0);
        unsigned nloc = b.st[0], nx = b.st[1];
        if (nloc == 0u) { xcd_barrier_complete(bar, b.x, nloc, nx); b.st[0] = nloc; b.st[1] = nx; }
        const unsigned old = xb_add(&bar[XB_XSUB(b.x)], 1u);
        const unsigned gen = old / nloc;
        if (old + 1u == (gen + 1u) * nloc) {
            __builtin_amdgcn_fence(__ATOMIC_RELEASE, "agent");
            asm volatile("s_waitcnt vmcnt(0)" ::: "memory");
            const unsigned og = xb_add(&bar[XB_TOP], 1u);
            if (og + 1u == (gen + 1u) * nx) xb_add(&bar[XB_TOPGEN], 1u);
            else XB_SPIN(xb_ld(&bar[XB_TOPGEN]) == gen, bar);
        } else {
            XB_SPIN(xb_ld(&bar[XB_TOPGEN]) == gen, bar);
        }
        __builtin_amdgcn_fence(__ATOMIC_ACQUIRE, "agent");
        asm volatile("s_waitcnt vmcnt(0)" ::: "memory");
    }
    __syncthreads();
}

namespace pg8 {
constexpr int BM = 256, BK = 64, HALF = 128, HTB = HALF * BK * 2;
__device__ __forceinline__ int lds_byte(int r, int c) { const int st = (r >> 4) * 2 + (c >> 5), rr = r & 15, cc = c & 31, ob = rr * 64 + cc * 2; return st * 1024 + (ob ^ (((ob >> 9) & 1) << 5)); }
__device__ __forceinline__ void stage_rc(int b, int& R, int& C) { const int st = b / 1024, sb = b % 1024, swz = sb ^ (((sb >> 9) & 1) << 5); R = (st >> 1) * 16 + swz / 64; C = (st & 1) * 32 + (swz % 64) / 2; }
__device__ __forceinline__ int perm32(int rho) { const int n = rho >> 4, i = rho & 15; return 8 * (i >> 2) + 4 * n + (i & 3); }

struct Unit { const char* A; const char* B; int pm, pn; };
struct Shape { int nt; unsigned lda, ldb; };

template <int NB, int SA, int SB, class Epi, class Sched>
__device__ __forceinline__ void gemm_phase(LAS unsigned char* lds, const int wid, const Shape g, const Sched& S, const Epi& E) {
    const int lane = lane_(), tid = wid * 64 + lane, wr = wid >> 2, wc = wid & 3, fr = lane & 15, fq = lane >> 4;
    const int nt = g.nt;
    unsigned voffA, voffB;
    { int R, C; stage_rc(tid * 16, R, C); const int Rb = (R & ~31) + perm32(R & 31); voffA = (unsigned)R * g.lda + (unsigned)C * 2u; voffB = (unsigned)Rb * g.ldb + (unsigned)C * 2u; }
    const size_t r64voffA = (size_t)64 * g.lda, r64voffB = (size_t)64 * g.ldb;
    const size_t kstep = (size_t)(BK * 2);
    const size_t hstepA = (size_t)HALF * g.lda, hstepB = (size_t)HALF * g.ldb;
    const unsigned ldsw = (unsigned)wid * 1024u;
    const int aoff = lds_byte(wr * 64 + fr, fq * 8), boff = lds_byte(wc * 32 + fr, fq * 8);
#define PG8_SA(b, h) (((b) * 2 + (h)) * HTB)
#define PG8_SB(b, h) ((4 + (b) * 2 + (h)) * HTB)
#define PG8_STAGE(bufoff, gbase, voff) do { _Pragma("unroll") for (int _i = 0; _i < 2; ++_i) { unsigned vo_ = (voff); asm volatile("" : "+v"(vo_)); \
        __builtin_amdgcn_global_load_lds((const unsigned*)((const char*)(gbase) + (_i ? r64##voff : (size_t)0) + vo_), (LAS unsigned*)(lds + (bufoff) + ldsw + _i * 8192), 16, 0, 0); } } while (0)
#define PG8_LDA(dst, b, h) do { _Pragma("unroll") for (int m = 0; m < 4; ++m) _Pragma("unroll") for (int k = 0; k < 2; ++k) dst[m][k] = *(const LAS bf16x8*)(lds + PG8_SA(b, h) + aoff + m * 2048 + k * 1024); } while (0)
#define PG8_LDB(dst, b, h) do { _Pragma("unroll") for (int n = 0; n < 2; ++n) _Pragma("unroll") for (int k = 0; k < 2; ++k) dst[n][k] = *(const LAS bf16x8*)(lds + PG8_SB(b, h) + boff + n * 2048 + k * 1024); } while (0)
#define PG8_MMA(ai, bj, At, Bt) do { __builtin_amdgcn_s_setprio(1); _Pragma("unroll") for (int m = 0; m < 4; ++m) _Pragma("unroll") for (int n = 0; n < 2; ++n) _Pragma("unroll") for (int k = 0; k < 2; ++k) \
        acc[ai][bj][m][n] = __builtin_amdgcn_mfma_f32_16x16x32_bf16(Bt[n][k], At[m][k], acc[ai][bj][m][n], 0, 0, 0); __builtin_amdgcn_s_setprio(0); } while (0)
#define PG8_MMA8(ai, bj, At, Bt) do { __builtin_amdgcn_s_setprio(1); _Pragma("unroll") for (int m = 0; m < 4; ++m) _Pragma("unroll") for (int n = 0; n < 2; ++n) { \
        const i32x8 a8_ = __builtin_shufflevector(__builtin_bit_cast(i32x4, At[m][0]), __builtin_bit_cast(i32x4, At[m][1]), 0, 1, 2, 3, 4, 5, 6, 7); \
        const i32x8 b8_ = __builtin_shufflevector(__builtin_bit_cast(i32x4, Bt[n][0]), __builtin_bit_cast(i32x4, Bt[n][1]), 0, 1, 2, 3, 4, 5, 6, 7); \
        acc[ai][bj][m][n] = __builtin_amdgcn_mfma_scale_f32_16x16x128_f8f6f4(b8_, a8_, acc[ai][bj][m][n], 0, 0, 0, SA, 0, SB); } __builtin_amdgcn_s_setprio(0); } while (0)

#define PG8_WAIT_V(n) asm volatile("s_waitcnt vmcnt(" #n ")" ::: "memory")
#define PG8_WAIT_L(n) asm volatile("s_waitcnt lgkmcnt(" #n ")" ::: "memory")
#define PG8_BAR __builtin_amdgcn_s_barrier()
#define PG8_SCHED __builtin_amdgcn_sched_barrier(0)
    Unit cur, nxt; int ui = 0;
    if (!S.next(0, cur)) return;
    f32x4 acc[2][2][4][2];
#pragma unroll
    for (int a = 0; a < 2; ++a)
#pragma unroll
        for (int b = 0; b < 2; ++b)
#pragma unroll
            for (int m = 0; m < 4; ++m)
#pragma unroll
                for (int n = 0; n < 2; ++n) acc[a][b][m][n] = (f32x4){0.f, 0.f, 0.f, 0.f};
    bf16x8 At[4][2], B0[2][2], B1[2][2];
    const char* cA = cur.A; const char* cB = cur.B;
    PG8_STAGE(PG8_SB(0, 0), cB, voffB); PG8_STAGE(PG8_SB(0, 1), cB + hstepB, voffB); PG8_STAGE(PG8_SA(0, 0), cA, voffA); PG8_STAGE(PG8_SA(0, 1), cA + hstepA, voffA);
    if (wr == 1) PG8_BAR;
    PG8_WAIT_V(2); PG8_BAR;
    PG8_STAGE(PG8_SB(1, 0), cB + kstep, voffB); PG8_STAGE(PG8_SA(1, 0), cA + kstep, voffA); PG8_STAGE(PG8_SB(1, 1), cB + hstepB + kstep, voffB);
    PG8_WAIT_V(6); PG8_BAR;
    for (;;) {
        const bool has_next = S.next(ui + 1, nxt);
        const char* nA = has_next ? nxt.A : cA; const char* nB = has_next ? nxt.B : cB;
#define PG8_ITER(MM) do { \
            const bool last = (t == nt - 2); \
            const char* a1 = cA + (size_t)(t + 1) * kstep; \
            const char* a2 = last ? nA : cA + (size_t)(t + 2) * kstep; const char* b2 = last ? nB : cB + (size_t)(t + 2) * kstep; \
            const char* a3 = a2 + kstep; const char* b3 = b2 + kstep; \
            PG8_LDB(B0, 0, 0); PG8_LDB(B1, 0, 1); PG8_SCHED; PG8_LDA(At, 0, 0); PG8_STAGE(PG8_SA(1, 1), a1 + hstepA, voffA); \
            PG8_WAIT_V(8); PG8_WAIT_L(0); PG8_BAR; MM(0, 0, At, B0); MM(0, 1, At, B1); PG8_BAR; PG8_SCHED; \
            PG8_LDA(At, 0, 1); PG8_STAGE(PG8_SB(0, 0), b2, voffB); PG8_STAGE(PG8_SB(0, 1), b2 + hstepB, voffB); PG8_STAGE(PG8_SA(0, 0), a2, voffA); \
            PG8_WAIT_V(8); PG8_WAIT_L(0); PG8_BAR; MM(1, 0, At, B0); MM(1, 1, At, B1); PG8_BAR; PG8_SCHED; \
            PG8_LDB(B0, 1, 0); PG8_LDB(B1, 1, 1); PG8_SCHED; PG8_LDA(At, 1, 0); PG8_STAGE(PG8_SA(0, 1), a2 + hstepA, voffA); \
            PG8_WAIT_V(8); PG8_WAIT_L(0); PG8_BAR; MM(0, 0, At, B0); MM(0, 1, At, B1); PG8_BAR; PG8_SCHED; \
            PG8_LDA(At, 1, 1); PG8_STAGE(PG8_SB(1, 0), b3, voffB); PG8_STAGE(PG8_SB(1, 1), b3 + hstepB, voffB); PG8_STAGE(PG8_SA(1, 0), a3, voffA); \
            PG8_WAIT_V(8); PG8_WAIT_L(0); PG8_BAR; MM(1, 0, At, B0); MM(1, 1, At, B1); PG8_BAR; PG8_SCHED; } while (0)
        int t = 0;
        if constexpr (NB != 0) {
            const int tb_end = NB < 0 ? nt : NB;
#pragma unroll 1
            for (; t < tb_end; t += 2) PG8_ITER(PG8_MMA);
        }
        if constexpr (NB >= 0) {
#pragma unroll 1
            for (; t < nt; t += 2) PG8_ITER(PG8_MMA8);
        }
        if (wr == 0) PG8_BAR;
        E(acc, cur, wr, wc, fr, fq);
        if (!has_next) break;
#pragma unroll
        for (int a = 0; a < 2; ++a)
#pragma unroll
            for (int b = 0; b < 2; ++b)
#pragma unroll
                for (int m = 0; m < 4; ++m)
#pragma unroll
                    for (int n = 0; n < 2; ++n) acc[a][b][m][n] = (f32x4){0.f, 0.f, 0.f, 0.f};
        cur = nxt; cA = nA; cB = nB; ++ui;
        if (wr == 1) PG8_BAR;
    }
    PG8_WAIT_V(0);
    PG8_BAR;
#undef PG8_SA
#undef PG8_SB
#undef PG8_STAGE
#undef PG8_LDA
#undef PG8_LDB
#undef PG8_MMA
#undef PG8_MMA8
#undef PG8_ITER
#undef PG8_WAIT_V
#undef PG8_WAIT_L
#undef PG8_BAR
#undef PG8_SCHED
}

struct DenseOrder {
    const char* A; const char* B; unsigned lda, ldb; int nM, nN, nwg, G, c;
    __device__ __forceinline__ void init(const void* A_, const void* B_, unsigned lda_, unsigned ldb_, int M, int N, int G_, int c_) { A = (const char*)A_; B = (const char*)B_; lda = lda_; ldb = ldb_; nM = M / 256; nN = N / 256; nwg = nM * nN; G = G_; c = c_; }
    __device__ __forceinline__ bool next(int i, Unit& u) const {
        const long L = (long)i * G + c; if (L >= nwg) return false;
        int wgid = (int)L; { const int q = nwg / 8, r = nwg % 8, xcd = wgid % 8, off = wgid / 8; wgid = (xcd < r ? xcd * (q + 1) : r * (q + 1) + (xcd - r) * q) + off; }
        const int nig = 8 * nN, gid = wgid / nig, fm = gid * 8, gsz = (nM - fm) < 8 ? (nM - fm) : 8;
        u.pm = fm + ((wgid % nig) % gsz); u.pn = (wgid % nig) / gsz;
        u.A = A + (size_t)u.pm * 256 * lda; u.B = B + (size_t)u.pn * 256 * ldb; return true;
    }
};
struct PoolOrder {
    const char* A; const char* B; int G, c, n;
    __device__ __forceinline__ bool next(int i, Unit& u) const {
        const int L = i * G + c; if (L >= n) return false;
        u.pm = L >> 2; u.pn = L & 3;
        u.A = A + (size_t)u.pm * 256 * 2048 + (size_t)u.pn * 512; u.B = B + (size_t)u.pn * 256 * 512; return true;
    }
};
struct RouterOrder {
    const char* A; const char* B; int G, c;
    __device__ __forceinline__ bool next(int i, Unit& u) const {
        const int L = i * G + c; if (L >= 256) return false;
        u.pm = L >> 2; u.pn = L & 3;
        u.A = A + (size_t)u.pm * 256 * (LDK * 2) + (size_t)u.pn * 2048; u.B = B + (size_t)u.pn * 2048; return true;
    }
};
struct GroupedOrder {
    const char* A; const char* B; unsigned lda, ldb; int NT, NCT, rowsPerE, G, c; const LAS int* tile_e;
    __device__ __forceinline__ bool next(int i, Unit& u) const {
        const int U = NT * NCT; const int L = i * G + c; if (L >= U) return false;
        const int q = U / 8, xcd = L % 8, off = L / 8; const int wgid = xcd * q + off;
        const int ti = wgid / NCT, pn = wgid % NCT; const int code = __builtin_amdgcn_readfirstlane(tile_e[ti]); const int e = code >> 3, rt = e * ETILES + (code & 7);
        u.pm = rt; u.pn = pn; u.A = A + (size_t)rt * 256 * lda; u.B = B + ((size_t)e * rowsPerE + (size_t)pn * 256) * ldb; return true;
    }
};
}

using pg8::Unit;
#define ACC_T f32x4 (&acc)[2][2][4][2]
__device__ __forceinline__ u32x4 pack8(f32x4 v0, f32x4 v1) { u32x4 w; w.x = cvt_pk_bf16(v0[0], v0[1]); w.y = cvt_pk_bf16(v0[2], v0[3]); w.z = cvt_pk_bf16(v1[0], v1[1]); w.w = cvt_pk_bf16(v1[2], v1[3]); return w; }

struct EpiProj {
    bf16_t *U, *Q, *K, *V; const float *qg, *kg; LAS float* xch; int skip, pn0;
    __device__ __forceinline__ void operator()(ACC_T, const Unit& u, int wr, int wc, int fr, int fq) const {
        if (skip) return;
        float zf = 0.f; asm volatile("" : "+v"(fr), "+v"(fq), "+v"(zf));
        const int ln = fq * 16 + fr;
        const int pn = u.pn + pn0; bf16_t* dst; int ldc, colt; bool norm = false; const float* gain = qg; float gs = 1.f;
        if (pn < 4) { dst = U; ldc = PW; colt = pn * 256; }
        else if (pn < 16) { dst = Q; ldc = AW; colt = (pn - 4) * 256; norm = true; gain = qg; gs = QSCALE * Q8_SCALE; }
        else if (pn < 28) { dst = K; ldc = AW; colt = (pn - 16) * 256; norm = true; gain = kg; gs = K8_SCALE; }
        else { dst = V; ldc = AW; colt = (pn - 28) * 256; }
        const bool f8out = pn >= 4;
        const int row0 = u.pm * 256 + wr * 64 + fr, col0 = colt + wc * 32 + 8 * fq;
        if (norm) {
            LAS float* xw = xch + (wr * 128 + fr) * 8 + wc; const LAS float* xr_ = xch + (wr * 128 + fr) * 8;
            asm volatile("" : "+v"(xw), "+v"(xr_));
#pragma unroll
            for (int ai = 0; ai < 2; ++ai)
#pragma unroll
                for (int m = 0; m < 4; ++m)
#pragma unroll
                    for (int bj = 0; bj < 2; ++bj) {
                        const f32x4 x0 = acc[ai][bj][m][0], x1 = acc[ai][bj][m][1];
                        float s = (x0[0] * x0[0] + x0[1] * x0[1]) + (x0[2] * x0[2] + x0[3] * x0[3]) + (x1[0] * x1[0] + x1[1] * x1[1]) + (x1[2] * x1[2] + x1[3] * x1[3]);
                        s += xor_lane(s, ln, 16); s += xor_lane(s, ln, 32);
                        if (fq == 0) xw[(ai * 64 + m * 16) * 8 + bj * 4] = s;
                    }
            asm volatile("s_waitcnt lgkmcnt(0)" ::: "memory"); __builtin_amdgcn_s_barrier(); asm volatile("" ::: "memory");
            f32x4 g0 = *(const f32x4*)(gain + wc * 32 + 8 * fq), g1 = *(const f32x4*)(gain + wc * 32 + 8 * fq + 4);
            g0 *= gs; g1 *= gs;
#pragma unroll
            for (int ai = 0; ai < 2; ++ai)
#pragma unroll
                for (int m = 0; m < 4; ++m)
#pragma unroll
                    for (int bj = 0; bj < 2; ++bj) {
                        const f32x4 p = *(const LAS f32x4*)&xr_[(ai * 64 + m * 16) * 8 + bj * 4];
                        const float rstd = __builtin_amdgcn_rsqf(((p[0] + p[1]) + (p[2] + p[3])) * (1.0f / 128.0f) + (EPS + zf));
                        acc[ai][bj][m][0] *= g0 * rstd; acc[ai][bj][m][1] *= g1 * rstd;
                    }
        }
        if (f8out) {
#pragma unroll
            for (int ai = 0; ai < 2; ++ai)
#pragma unroll
                for (int m = 0; m < 4; ++m) { unsigned char* rowp = (unsigned char*)dst + (size_t)(row0 + ai * 128 + m * 16) * AW + col0;
#pragma unroll
                    for (int bj = 0; bj < 2; ++bj) { const float vs = norm ? 1.0f : V8_SCALE; const f32x4 v0 = acc[ai][bj][m][0] * vs, v1 = acc[ai][bj][m][1] * vs; u32x2 w; w.x = pk4_fp8(v0[0], v0[1], v0[2], v0[3]); w.y = pk4_fp8(v1[0], v1[1], v1[2], v1[3]);
                        *(u32x2*)(rowp + bj * 128) = w; } }
            return;
        }
#pragma unroll
        for (int ai = 0; ai < 2; ++ai)
#pragma unroll
            for (int m = 0; m < 4; ++m) { bf16_t* rowp = dst + (size_t)(row0 + ai * 128 + m * 16) * ldc + col0;
#pragma unroll
                for (int bj = 0; bj < 2; ++bj) *(u32x4*)(rowp + bj * 128) = pack8(acc[ai][bj][m][0], acc[ai][bj][m][1]); }
    }
};
struct EpiPool {
    unsigned char* Y; const float* scale;
    __device__ __forceinline__ void operator()(ACC_T, const Unit& u, int wr, int wc, int fr, int fq) const {
        const int row0 = u.pm * 256 + wr * 64 + fr, col0 = u.pn * 256 + wc * 32 + 8 * fq;
        f32x4 sc[2][2];
#pragma unroll
        for (int bj = 0; bj < 2; ++bj)
#pragma unroll
            for (int n = 0; n < 2; ++n) sc[bj][n] = scale ? *(const f32x4*)(scale + col0 + bj * 128 + 4 * n) : (f32x4){1.f, 1.f, 1.f, 1.f};
#pragma unroll
        for (int ai = 0; ai < 2; ++ai)
#pragma unroll
            for (int m = 0; m < 4; ++m) { bf16_t* rowp = (bf16_t*)(Y + (size_t)(row0 + ai * 128 + m * 16) * LDM) + col0;
#pragma unroll
                for (int bj = 0; bj < 2; ++bj) *(u32x4*)(rowp + bj * 128) = pack8(acc[ai][bj][m][0] * sc[bj][0], acc[ai][bj][m][1] * sc[bj][1]); }
    }
};
struct EpiOut {
    const float* g1; const float* inv_rstd; bf16_t* x1b; float* ssq; int skip;
    __device__ __forceinline__ void operator()(ACC_T, const Unit& u, int wr, int wc, int fr, int fq) const {
        if (skip) return;
        const int row0 = u.pm * 256 + wr * 64 + fr, col0 = u.pn * 256 + wc * 32 + 8 * fq;
        f32x4 ig[2][2];
#pragma unroll
        for (int bj = 0; bj < 2; ++bj)
#pragma unroll
            for (int q = 0; q < 2; ++q) { const f32x4 g = *(const f32x4*)(g1 + col0 + bj * 128 + 4 * q);
                ig[bj][q] = (f32x4){__builtin_amdgcn_rcpf(g[0]), __builtin_amdgcn_rcpf(g[1]), __builtin_amdgcn_rcpf(g[2]), __builtin_amdgcn_rcpf(g[3])}; }
        u32x4 hr[8][2]; float xs[8];
#define EO_LOAD(it) do { const int r_ = row0 + ((it) >> 2) * 128 + ((it) & 3) * 16; const bf16_t* hp_ = x1b + (size_t)r_ * LDK + col0; \
        hr[it][0] = *(const u32x4*)hp_; hr[it][1] = *(const u32x4*)(hp_ + 128); xs[it] = inv_rstd[r_]; } while (0)
        EO_LOAD(0); EO_LOAD(1); EO_LOAD(2); EO_LOAD(3);
#pragma unroll
        for (int it = 0; it < 8; ++it) { const int ai = it >> 2, m = it & 3; const int r = row0 + ai * 128 + m * 16; float s = 0.f;
            if (it + 4 < 8) EO_LOAD(it + 4);
#pragma unroll
            for (int bj = 0; bj < 2; ++bj) { const u32x4 w = hr[it][bj]; const float sc = xs[it];
                const f32x4 h0 = {__uint_as_float(w.x << 16), __uint_as_float(w.x & 0xffff0000u), __uint_as_float(w.y << 16), __uint_as_float(w.y & 0xffff0000u)};
                const f32x4 h1 = {__uint_as_float(w.z << 16), __uint_as_float(w.z & 0xffff0000u), __uint_as_float(w.w << 16), __uint_as_float(w.w & 0xffff0000u)};
                const f32x4 v0 = acc[ai][bj][m][0] + h0 * ig[bj][0] * sc, v1 = acc[ai][bj][m][1] + h1 * ig[bj][1] * sc;
                s += (v0[0] * v0[0] + v0[1] * v0[1]) + (v0[2] * v0[2] + v0[3] * v0[3]) + (v1[0] * v1[0] + v1[1] * v1[1]) + (v1[2] * v1[2] + v1[3] * v1[3]);
                *(u32x4*)(x1b + (size_t)r * LDK + col0 + bj * 128) = pack8(v0, v1);
            }
            s += __shfl_xor(s, 16); s += __shfl_xor(s, 32);
            if (fq == 0) ssq[(size_t)r * 64 + u.pn * 4 + wc] = s;
            asm volatile("" ::: "memory"); }
#undef EO_LOAD
    }
};
struct EpiLogits {
    float* lg;
    __device__ __forceinline__ void operator()(ACC_T, const Unit& u, int wr, int wc, int fr, int fq) const {
        if (wc >= 2) return;
        const int row0 = u.pm * 256 + wr * 64 + fr, col0 = wc * 32 + 8 * fq;
#pragma unroll
        for (int ai = 0; ai < 2; ++ai)
#pragma unroll
            for (int m = 0; m < 4; ++m) { float* rowp = lg + (size_t)u.pn * (NTOK * 64) + (size_t)(row0 + ai * 128 + m * 16) * 64 + col0;
                *(f32x4*)(rowp) = acc[ai][0][m][0]; *(f32x4*)(rowp + 4) = acc[ai][0][m][1]; }
    }
};
struct EpiSwiglu {
    unsigned char* Ab; const float* row_gate;
    __device__ __forceinline__ void operator()(ACC_T, const Unit& u, int wr, int wc, int fr, int fq) const {
        const int row0 = u.pm * 256 + wr * 64 + fr, col0 = u.pn * 128 + wc * 32 + 8 * fq;
#pragma unroll
        for (int ai = 0; ai < 2; ++ai)
#pragma unroll
            for (int m = 0; m < 4; ++m) { const int r = row0 + ai * 128 + m * 16; const float gt = row_gate[r] * A_SCALE; f32x4 a[2];
#pragma unroll
                for (int n = 0; n < 2; ++n) { const f32x4 gv = acc[ai][0][m][n], uv = acc[ai][1][m][n];
#pragma unroll
                    for (int j = 0; j < 4; ++j) { const float sg = __builtin_amdgcn_rcpf(1.0f + __builtin_amdgcn_exp2f(-gv[j] * LOG2E)); a[n][j] = gv[j] * sg * uv[j] * gt; } }
                u32x2 w; w.x = pk4_fp8(a[0][0], a[0][1], a[0][2], a[0][3]); w.y = pk4_fp8(a[1][0], a[1][1], a[1][2], a[1][3]);
                *(u32x2*)(Ab + (size_t)r * LDE8 + col0) = w; }
    }
};
struct EpiDown {
    unsigned char* Y;
    __device__ __forceinline__ void operator()(ACC_T, const Unit& u, int wr, int wc, int fr, int fq) const {
        const int row0 = u.pm * 256 + wr * 64 + fr, col0 = u.pn * 256 + wc * 32 + 8 * fq;
#pragma unroll
        for (int ai = 0; ai < 2; ++ai)
#pragma unroll
            for (int m = 0; m < 4; ++m) { const int r = row0 + ai * 128 + m * 16; unsigned char* rowp = Y + (size_t)r * DM + col0;
#pragma unroll
                for (int bj = 0; bj < 2; ++bj) { const f32x4 v0 = acc[ai][bj][m][0], v1 = acc[ai][bj][m][1]; u32x2 w; w.x = pk4_fp8(v0[0], v0[1], v0[2], v0[3]); w.y = pk4_fp8(v1[0], v1[1], v1[2], v1[3]);
                    *(u32x2*)(rowp + bj * 128) = w; } }
    }
};
struct Params { const float* in[17]; float* out; unsigned char* ws; int ph_lo, ph_hi, flags, pad; };
struct Frame {
    LAS unsigned char* lds; int wave, G, bx, vcu;
    unsigned char* ws; unsigned* ctl;
};
#define tid_() (F.wave * 64 + lane_())

struct TrTile { const float* src; bf16_t* dst; const float* kscale; int ldw, ldt, drow0, k0; float sc8; };
__device__ __forceinline__ TrTile tr_decode(const Params& P, unsigned char* ws, int t) {
    bf16_t* WinU = (bf16_t*)(ws + WS_WINU); unsigned char* Win8 = ws + WS_WIN8; unsigned char* Wout = ws + WS_WOUT; unsigned char* WguT = ws + WS_WGU; unsigned char* WdT = ws + WS_WD; bf16_t* GwT = (bf16_t*)(ws + WS_GW);
    constexpr int T_IN = 32 * 80, T_OUT = 32 * 32, T_GU = 32 * 512, T_D = 32 * 256;
    TrTile r; r.sc8 = 0.f; r.kscale = nullptr; int q = t;
    if (q < T_IN) { const int kt = q / 80, nt = q % 80; r.src = P.in[2] + (size_t)kt * 128 * INW + nt * 128; r.ldw = INW; r.k0 = kt * 128;
        if (nt < 8) { r.dst = WinU; r.ldt = LDK; r.drow0 = nt * 128; } else { r.dst = (bf16_t*)Win8; r.ldt = LDK8; r.drow0 = (nt - 8) * 128; r.sc8 = WIN_SCALE; }
        return r; } q -= T_IN;
    if (q < T_OUT) { const int kt = q / 32, nt = q % 32; r.src = P.in[8] + (size_t)kt * 128 * DM + nt * 128; r.ldw = DM; r.drow0 = nt * 128; r.k0 = kt * 128;
        if (kt < 8) { r.dst = (bf16_t*)(ws + WS_POOLED); r.ldt = PW; }
        else { r.dst = (bf16_t*)(Wout + 1024); r.ldt = LDM; r.sc8 = WOUT_SCALE; }
        return r; } q -= T_OUT;
    if (q < T_GU) { const int e = q / 512, r1 = q % 512, which = r1 / 256, r2 = r1 % 256, kt = r2 / 8, nt = r2 % 8;
        r.src = (which ? P.in[15] : P.in[14]) + (size_t)e * DM * DE + (size_t)kt * 128 * DE + nt * 128; r.ldw = DE; r.dst = (bf16_t*)(WguT + (size_t)e * 2048 * LDK8); r.ldt = LDK8; r.sc8 = WGU_SCALE; r.kscale = P.in[9]; r.drow0 = nt * 256 + which * 128; r.k0 = kt * 128; return r; } q -= T_GU;
    { const int e = q / 256, r1 = q % 256, kt = r1 / 32, nt = r1 % 32;
        r.src = P.in[16] + (size_t)e * DE * DM + (size_t)kt * 128 * DM + nt * 128; r.ldw = DM; r.dst = (bf16_t*)(WdT + (size_t)e * DM * LDE8); r.ldt = LDE8; r.sc8 = WD_SCALE; r.drow0 = nt * 128; r.k0 = kt * 128; return r; }
}
__device__ __forceinline__ void p0_prologue(const Frame& F, const Params& P) {
    const int tid = tid_(), lane = tid & 63;
    bf16_t* WrT = (bf16_t*)(F.ws + WS_WR); bf16_t* Hb = (bf16_t*)(F.ws + WS_H); unsigned char* H8 = F.ws + WS_H8;
    constexpr int T_ALL = 32 * 80 + 32 * 32 + 32 * 512 + 32 * 256;
    {
        LAS unsigned char* T = F.lds;
        const int l = lane, h = l >> 5, blk = (l >> 4) & 1, q = (l & 15) >> 2, p = l & 3, i16 = l & 15;
        const int nb = 2 * (F.wave & 3) + blk;
        const int lrow = tid >> 5, lc4 = tid & 31;
        f32x4 v[8];
        int t = F.vcu;
        TrTile cur = tr_decode(P, F.ws, t < T_ALL ? t : 0);
        if (t < T_ALL) {
#pragma unroll
            for (int j = 0; j < 8; ++j) v[j] = *(const f32x4*)(cur.src + (size_t)(lrow + 16 * j) * cur.ldw + lc4 * 4);
        }
        for (; t < T_ALL; t += F.G) {
            if (cur.kscale) {
#pragma unroll
                for (int j = 0; j < 8; ++j) v[j] *= cur.kscale[cur.k0 + lrow + 16 * j]; }
#pragma unroll
            for (int j = 0; j < 8; ++j) { u32x2 w; w.x = cvt_pk_bf16(v[j][0], v[j][1]); w.y = cvt_pk_bf16(v[j][2], v[j][3]); *(LAS u32x2*)(T + (lrow + 16 * j) * 320 + lc4 * 8) = w; }
            __syncthreads();
            const int tn = t + F.G; const TrTile nx = tr_decode(P, F.ws, tn < T_ALL ? tn : 0);
            if (tn < T_ALL) {
#pragma unroll
                for (int j = 0; j < 8; ++j) v[j] = *(const f32x4*)(nx.src + (size_t)(lrow + 16 * j) * nx.ldw + lc4 * 4);
            }
            if (cur.sc8 == 0.f) {
#pragma unroll
            for (int it = 0; it < 4; ++it) { const int kc8 = 8 * (F.wave >> 2) + 2 * it + h;
                const s16x4 lo = __builtin_amdgcn_ds_read_tr16_b64_v4i16((LAS s16x4*)(T + (8 * kc8 + q) * 320 + nb * 32 + 8 * p));
                const s16x4 hi = __builtin_amdgcn_ds_read_tr16_b64_v4i16((LAS s16x4*)(T + (8 * kc8 + 4 + q) * 320 + nb * 32 + 8 * p));
                const bf16x8 o = __builtin_shufflevector(lo, hi, 0, 1, 2, 3, 4, 5, 6, 7);
                *(bf16x8*)(cur.dst + (size_t)(cur.drow0 + nb * 16 + i16) * cur.ldt + cur.k0 + 8 * kc8) = o; }
            } else {
                unsigned char* d8 = (unsigned char*)cur.dst;
#pragma unroll
            for (int it = 0; it < 2; ++it) { const int kc16 = 4 * (F.wave >> 2) + 2 * it + h; u32x4 o;
#pragma unroll
                for (int hh = 0; hh < 2; ++hh) { const int kc8 = 2 * kc16 + hh;
                    const s16x4 lo = __builtin_amdgcn_ds_read_tr16_b64_v4i16((LAS s16x4*)(T + (8 * kc8 + q) * 320 + nb * 32 + 8 * p));
                    const s16x4 hi = __builtin_amdgcn_ds_read_tr16_b64_v4i16((LAS s16x4*)(T + (8 * kc8 + 4 + q) * 320 + nb * 32 + 8 * p));
                    const bf16x8 b8 = __builtin_shufflevector(lo, hi, 0, 1, 2, 3, 4, 5, 6, 7);
                    const u32x2 f8 = bf16x8_to_fp8(__builtin_bit_cast(u32x4, b8), cur.sc8); o[2 * hh] = f8.x; o[2 * hh + 1] = f8.y; }
                *(u32x4*)(d8 + (size_t)(cur.drow0 + nb * 16 + i16) * cur.ldt + cur.k0 + 16 * kc16) = o; }
            }
            __syncthreads();
            cur = nx;
        }
    }
    { const float* gw = P.in[3]; const float* ps = P.in[4]; bf16_t* Gs = (bf16_t*)(F.ws + WS_GW);
      for (int i = F.vcu * 512 + tid; i < 4 * 65536; i += F.G * 512) { const int g = i >> 16, d = i & 255; Gs[i] = (bf16_t)(cvt_pk_bf16(gw[i] * ps[g * 256 + d], 0.f) & 0xffffu); } }
    { const float* wrg = P.in[10]; const float* wre = P.in[12];
      for (int i = F.vcu * 512 + tid; i < 256 * DM; i += F.G * 512) { const int row = i >> 12, k = i & 4095; float v = 0.f;
          if (row < 4) v = wrg[k * 4 + row]; else if (row < 36) { const int g = (row - 4) >> 3, j = (row - 4) & 7; v = wre[((size_t)g * DM + k) * 8 + j]; }
          v *= P.in[9][k];
          WrT[(size_t)row * LDK + k] = (bf16_t)(cvt_pk_bf16(v, 0.f) & 0xffffu); } }
    { const float* x = P.in[0]; const float* g1 = P.in[1]; const int gw = F.vcu * 8 + F.wave, NGW = F.G * 8;
      for (int m = gw; m < NTOK; m += NGW) { const f32x4* xr = (const f32x4*)(x + (size_t)m * DM) + lane; f32x4 v[16]; float s = 0.f;
#pragma unroll
          for (int j = 0; j < 16; ++j) { v[j] = xr[64 * j]; s += (v[j][0] * v[j][0] + v[j][1] * v[j][1]) + (v[j][2] * v[j][2] + v[j][3] * v[j][3]); }
          const float rstd = __builtin_amdgcn_rsqf(wave_sum(s) * (1.0f / DM) + EPS);
          if (lane == 0) ((float*)(F.ws + WS_TOK))[TM_RSTD + m] = 1.0f / rstd;
          u32x2* o = (u32x2*)(Hb + (size_t)m * LDK) + lane; unsigned* o8 = (unsigned*)(H8 + (size_t)m * LDK8) + lane; const f32x4* gp = (const f32x4*)g1 + lane;
#pragma unroll
          for (int j = 0; j < 16; ++j) { const f32x4 gg = gp[64 * j]; const float h0 = v[j][0] * rstd * gg[0], h1 = v[j][1] * rstd * gg[1], h2 = v[j][2] * rstd * gg[2], h3 = v[j][3] * rstd * gg[3];
              u32x2 w; w.x = cvt_pk_bf16(h0, h1); w.y = cvt_pk_bf16(h2, h3); o[64 * j] = w; o8[64 * j] = pk4_fp8(h0, h1, h2, h3); } } }
}

template <int W> struct PoolV { u32x4 v[W]; };
template <int W> __device__ __forceinline__ void pooled_load(PoolV<W>& p, const bf16_t* U, int t, int s, int cc) {
#pragma unroll
    for (int j = 0; j < W; ++j) { const int d = (s - j) >= 0 ? j : 0; p.v[j] = *(const u32x4*)(U + (size_t)(t - d) * PW + cc * 8); }
}
template <int W> __device__ __forceinline__ void pooled_finish(const PoolV<W>& p, unsigned char* Pd, int t, int s, int cc) {
    float a[8];
#pragma unroll
    for (int q = 0; q < 8; ++q) a[q] = 0.f;
#pragma unroll
    for (int j = 0; j < W; ++j) { const float wgt = (s - j) >= 0 ? 1.f : 0.f;
#pragma unroll
        for (int q = 0; q < 4; ++q) { a[2 * q] += wgt * __uint_as_float(p.v[j][q] << 16); a[2 * q + 1] += wgt * __uint_as_float(p.v[j][q] & 0xffff0000u); } }
    const int cnt = (s + 1) < W ? (s + 1) : W; const float inv = 1.0f / (float)cnt; u32x4 o;
#pragma unroll
    for (int q = 0; q < 4; ++q) o[q] = cvt_pk_bf16(a[2 * q] * inv - __uint_as_float(p.v[0][q] << 16), a[2 * q + 1] * inv - __uint_as_float(p.v[0][q] & 0xffff0000u));
    *(u32x4*)(Pd + (size_t)t * LDM + cc * 16) = o;
}
__device__ __forceinline__ void p2_pooled(const Frame& F) {
    const int lane = lane_();
    const bf16_t* U = (const bf16_t*)(F.ws + WS_U); unsigned char* Pd = F.ws + WS_YCAT;
    for (int tp = F.vcu * 8 + F.wave; tp < NTOK / 2; tp += F.G * 8) {
        const int t = 2 * tp + (lane >> 5), s = t & (SEQ - 1), c5 = lane & 31;
        PoolV<2> p0; PoolV<4> p1; PoolV<8> p2; PoolV<16> p3;
        pooled_load<2>(p0, U, t, s, c5); pooled_load<4>(p1, U, t, s, 32 + c5); pooled_load<8>(p2, U, t, s, 64 + c5); pooled_load<16>(p3, U, t, s, 96 + c5);
        pooled_finish<2>(p0, Pd, t, s, c5); pooled_finish<4>(p1, Pd, t, s, 32 + c5); pooled_finish<8>(p2, Pd, t, s, 64 + c5); pooled_finish<16>(p3, Pd, t, s, 96 + c5);
    }
}
typedef float f32x2_t __attribute__((ext_vector_type(2)));
typedef __bf16 bf16x2_t __attribute__((ext_vector_type(2)));
__device__ __forceinline__ unsigned cvtpk_c(float lo, float hi) { const f32x2_t v = {lo, hi}; const bf16x2_t b = __builtin_convertvector(v, bf16x2_t); return __builtin_bit_cast(unsigned, b); }
#define MFMA32(a, b, c) __builtin_amdgcn_mfma_f32_32x32x16_bf16((a), (b), (c), 0, 0, 0)
__device__ __forceinline__ bf16x8 pack_lo8(const f32x16& x) { u32x4 p; p.x = cvt_pk_bf16(x[0], x[1]); p.y = cvt_pk_bf16(x[2], x[3]); p.z = cvt_pk_bf16(x[4], x[5]); p.w = cvt_pk_bf16(x[6], x[7]); return __builtin_bit_cast(bf16x8, p); }
__device__ __forceinline__ bf16x8 pack_hi8(const f32x16& x) { u32x4 p; p.x = cvt_pk_bf16(x[8], x[9]); p.y = cvt_pk_bf16(x[10], x[11]); p.z = cvt_pk_bf16(x[12], x[13]); p.w = cvt_pk_bf16(x[14], x[15]); return __builtin_bit_cast(bf16x8, p); }
__device__ __forceinline__ void p2_attention(const Frame& F, const float* rel_bias) {
    const unsigned char* Q8 = F.ws + WS_Q; const unsigned char* K8 = F.ws + WS_K; const unsigned char* V8 = F.ws + WS_V; unsigned char* Yc = F.ws + WS_YCAT;
    LAS unsigned char* lds = F.lds; LAS float* btab = (LAS float*)(lds + 98304);
    const int tid = tid_(), lane = tid & 63, wid = F.wave, l31 = lane & 31, h = lane >> 5;
    const unsigned ka0 = (unsigned)(l31 * 128 + (((2 * h) ^ ((l31 >> 1) & 7)) << 4)), ka1 = (unsigned)(l31 * 128 + (((2 * h + 1) ^ ((l31 >> 1) & 7)) << 4));
    unsigned vb4[4];
    { const int r = (lane & 15) >> 1, cc = lane & 1, g16 = (lane >> 4) & 1, key0 = (r & 3) + 8 * (r >> 2) + 4 * h, sw = (key0 >> 1) & 7;
#pragma unroll
      for (int db = 0; db < 4; ++db) vb4[db] = (unsigned)(key0 * 128 + 16 * ((2 * db + g16) ^ sw) + 8 * cc); }
    unsigned ksrc;
    { const int p = wid * 64 + lane, row = p >> 3, ch = (p & 7) ^ ((row >> 1) & 7); ksrc = (unsigned)(row * AW + ch * 16); }
    for (int unit = F.vcu; unit < NTOK / 256 * NH; unit += F.G) {
        const int bh = unit >> 4, qb = (unit + bh) & 15, hd = bh % NH, b = bh / NH;
        const int tb = b * SEQ, c0 = 4 * qb, c = c0 + (wid >> 1), qrow = c * 64 + (wid & 1) * 32 + l31;
        const int kc_lo = (c0 - 8) > 0 ? (c0 - 8) : 0, kc_hi = c0 + 3;
        __syncthreads();
        if (tid < 320) btab[tid] = (rel_bias[hd * NREL + (tid < NREL - 1 ? tid : NREL - 1)] - rel_bias[hd * NREL + NREL - 1]) * LOG2E;
        i32x8 qf[2];
        { const unsigned char* qp = Q8 + (size_t)(tb + qrow) * AW + hd * HD + 32 * h;
#pragma unroll
          for (int j = 0; j < 2; ++j) { const i32x4 lo = *(const i32x4*)(qp + 64 * j), hi = *(const i32x4*)(qp + 64 * j + 16); qf[j] = __builtin_shufflevector(lo, hi, 0, 1, 2, 3, 4, 5, 6, 7); } }
#define ATT_ISSUE(kc, buf) do { const char* kg_ = (const char*)K8 + ((size_t)(tb + (kc) * 64) * AW + hd * HD); const char* vg_ = (const char*)V8 + ((size_t)(tb + (kc) * 64) * AW + hd * HD); \
        __builtin_amdgcn_global_load_lds((const unsigned*)(kg_ + ksrc), (LAS unsigned*)(lds + (buf) * 32768 + wid * 1024), 16, 0, 0);     \
        __builtin_amdgcn_global_load_lds((const unsigned*)(vg_ + ksrc), (LAS unsigned*)(lds + (buf) * 32768 + 16384 + wid * 1024), 16, 0, 0); } while (0)
        ATT_ISSUE(kc_lo, 0);
        if (kc_lo < kc_hi) ATT_ISSUE(kc_lo + 1, 1);
        float mrun = 0.f, lsum = 0.f; f32x16 O[4];
#pragma unroll
        for (int d = 0; d < 4; ++d)
#pragma unroll
            for (int r = 0; r < 16; ++r) O[d][r] = 0.f;
        int buf = 0;
        for (int kc = kc_lo; kc <= kc_hi; ++kc) {
            if (kc < kc_hi) asm volatile("s_waitcnt vmcnt(2)" ::: "memory"); else asm volatile("s_waitcnt vmcnt(0)" ::: "memory");
            __syncthreads();
            if (kc + 2 <= kc_hi) ATT_ISSUE(kc + 2, (buf >= 1 ? buf - 1 : 2));
            if (kc >= c - 8 && kc <= c) {
                const LAS unsigned char* Kb = lds + buf * 32768; const LAS unsigned char* Vb = lds + buf * 32768 + 16384;
#define ATT_KF(hk, j) __builtin_shufflevector(*(const LAS i32x4*)(Kb + (hk) * 4096 + (ka0 ^ (64u * (j)))), *(const LAS i32x4*)(Kb + (hk) * 4096 + (ka1 ^ (64u * (j)))), 0, 1, 2, 3, 4, 5, 6, 7)
#define ATT_QK(S, kf, j) S = __builtin_amdgcn_mfma_scale_f32_32x32x64_f8f6f4((kf), qf[j], S, 0, 0, 0, 0x7C7C7C7C, 0, 0x7A7A7A7A)
                f32x16 S0, S1; i32x8 kf0[2], kf1[2];
                kf0[0] = ATT_KF(0, 0); kf0[1] = ATT_KF(0, 1);
                if (kc > c - 3) { const LAS float* bp = btab + (qrow - kc * 64 - 4 * h + (128 - 59));
#pragma unroll
                    for (int r = 0; r < 16; ++r) { const int ko = (r & 3) + 8 * (r >> 2); S0[r] = bp[59 - ko] - mrun; S1[r] = bp[27 - ko] - mrun; }
                } else {
#pragma unroll
                    for (int r = 0; r < 16; ++r) { S0[r] = -mrun; S1[r] = -mrun; }
                }
                __builtin_amdgcn_sched_barrier(0);
                kf1[0] = ATT_KF(1, 0); kf1[1] = ATT_KF(1, 1);
                __builtin_amdgcn_sched_barrier(0);
                ATT_QK(S0, kf0[0], 0); ATT_QK(S0, kf0[1], 1);
                __builtin_amdgcn_sched_barrier(0);
                const unsigned vbase = (unsigned)(size_t)Vb;
                u32x2 vr[4][4];
#define ATT_VREAD(dst, db) asm volatile("ds_read_b64_tr_b8 %0, %4\n\tds_read_b64_tr_b8 %1, %4 offset:2048\n\tds_read_b64_tr_b8 %2, %4 offset:4096\n\tds_read_b64_tr_b8 %3, %4 offset:6144" \
                    : "=&v"(dst[0]), "=&v"(dst[1]), "=&v"(dst[2]), "=&v"(dst[3]) : "v"(vbase + vb4[db]) : "memory")
#define ATT_VWAIT(dst) asm volatile("s_waitcnt lgkmcnt(0)" : "+v"(dst[0]), "+v"(dst[1]), "+v"(dst[2]), "+v"(dst[3]) :: "memory")
                ATT_VREAD(vr[0], 0); ATT_VREAD(vr[1], 1);
                __builtin_amdgcn_sched_barrier(0);
                float ps = 0.f; int pk[8];
#pragma unroll
                for (int w = 0; w < 8; ++w) pk[w] = 0;
#define ATT_SM(S, hf, i) do { const float e0_ = __builtin_amdgcn_exp2f(fminf(S[2 * (i)], 15.0f)), e1_ = __builtin_amdgcn_exp2f(fminf(S[2 * (i) + 1], 15.0f)); ps += e0_; ps += e1_; \
                    pk[(hf) * 4 + ((i) >> 1)] = __builtin_amdgcn_cvt_pk_bf8_f32(e0_, e1_, pk[(hf) * 4 + ((i) >> 1)], ((i) & 1) != 0); } while (0)
                ATT_QK(S1, kf1[0], 0);
                __builtin_amdgcn_sched_barrier(0);
                ATT_QK(S1, kf1[1], 1); ATT_SM(S0, 0, 0); ATT_SM(S0, 0, 1); ATT_SM(S0, 0, 2); ATT_SM(S0, 0, 3);
                __builtin_amdgcn_sched_barrier(0);
                ATT_SM(S0, 0, 4); ATT_SM(S0, 0, 5); ATT_SM(S0, 0, 6); ATT_SM(S0, 0, 7);
                __builtin_amdgcn_sched_barrier(0);
                ATT_VREAD(vr[2], 2); ATT_VREAD(vr[3], 3);
                __builtin_amdgcn_sched_barrier(0);
                ATT_SM(S1, 1, 0); ATT_SM(S1, 1, 1); ATT_SM(S1, 1, 2); ATT_SM(S1, 1, 3); ATT_SM(S1, 1, 4); ATT_SM(S1, 1, 5); ATT_SM(S1, 1, 6); ATT_SM(S1, 1, 7);
                __builtin_amdgcn_sched_barrier(0);
                ATT_VWAIT(vr[0]); ATT_VWAIT(vr[1]); ATT_VWAIT(vr[2]); ATT_VWAIT(vr[3]);
                { const i32x8 pf = {pk[0], pk[1], pk[2], pk[3], pk[4], pk[5], pk[6], pk[7]};
#pragma unroll
                  for (int db = 0; db < 4; ++db) { const i32x8 vf = {(int)vr[db][0].x, (int)vr[db][0].y, (int)vr[db][1].x, (int)vr[db][1].y, (int)vr[db][2].x, (int)vr[db][2].y, (int)vr[db][3].x, (int)vr[db][3].y};
                      O[db] = __builtin_amdgcn_mfma_scale_f32_32x32x64_f8f6f4(vf, pf, O[db], 0, 1, 0, 0x7C7C7C7C, 0, 0x7F7F7F7F); } }
#undef ATT_SM
#undef ATT_KF
#undef ATT_QK
                lsum += ps;
                if (__any(ps > 4096.0f)) {
                    const float pm = fmaxf(ps, __shfl_xor(ps, 32)); const float dl = pm > 256.0f ? floorf(__builtin_amdgcn_logf(pm)) : 0.f, alpha = __builtin_amdgcn_exp2f(-dl); mrun += dl; lsum *= alpha;
#pragma unroll
                    for (int d = 0; d < 4; ++d)
#pragma unroll
                        for (int r = 0; r < 16; ++r) O[d][r] *= alpha;
                }
#undef ATT_VREAD
#undef ATT_VWAIT
            }
            buf = (buf == 2) ? 0 : buf + 1;
        }
#undef ATT_ISSUE
        lsum += __shfl_xor(lsum, 32);
        const float inv = 1.0f / lsum;
        const float inv64 = inv * YA_SCALE;
        unsigned char* yp = Yc + (size_t)(tb + qrow) * LDM + 2048 + hd * HD + 4 * h;
#pragma unroll
        for (int d = 0; d < 4; ++d)
#pragma unroll
            for (int g = 0; g < 4; ++g) *(unsigned*)(yp + 32 * d + 8 * g) = pk4_fp8(O[d][4 * g] * inv64, O[d][4 * g + 1] * inv64, O[d][4 * g + 2] * inv64, O[d][4 * g + 3] * inv64);
    }
}

__device__ __forceinline__ void p6_route_scatter(const Frame& F, const Params& P) {
    const int lane = lane_(), tid = F.wave * 64 + lane;
    const float* lg = (const float*)(F.ws + WS_LOG); const float* ssq = (const float*)(F.ws + WS_SSQ);
    unsigned* tm = (unsigned*)(F.ws + WS_TOK); float* rm = (float*)(F.ws + WS_ROW); const bf16_t* xg = (const bf16_t*)(F.ws + WS_H); unsigned char* Xs = F.ws + WS_XS;
    unsigned* gcnt = F.ctl + CW_CNT;
    LAS unsigned* lcnt = (LAS unsigned*)(F.lds + LDS_TAB); LAS unsigned* lbase = lcnt + 32; LAS unsigned* dpair = lcnt + 64; LAS float* rsl = (LAS float*)(lcnt + 192);
    const float* brg = P.in[11]; const float* bre = P.in[13];
    for (int tb = F.vcu; tb < NTOK / 64; tb += F.G) {
        __syncthreads();
        if (tid < 32) lcnt[tid] = 0u;
        __syncthreads();
        int e1 = 0, e2 = 0; unsigned p1 = 0, p2 = 0; float g1 = 0.f, g2 = 0.f, rstd = 0.f; const int t = tb * 64 + tid;
        if (tid < 64) {
            float s = 0.f;
            for (int j = 0; j < 64; ++j) s += ssq[(size_t)t * 64 + j];
            rstd = 1.0f / sqrtf(s * (1.0f / DM) + EPS);
            float l4[4]; int gi = 0;
#pragma unroll
            for (int j = 0; j < 4; ++j) l4[j] = ((lg[(size_t)t * 64 + j] + lg[(size_t)NTOK * 64 + (size_t)t * 64 + j]) + (lg[(size_t)2 * NTOK * 64 + (size_t)t * 64 + j] + lg[(size_t)3 * NTOK * 64 + (size_t)t * 64 + j])) * rstd + brg[j];
#pragma unroll
            for (int j = 1; j < 4; ++j) if (l4[j] > l4[gi]) gi = j;
            float den = 0.f;
#pragma unroll
            for (int j = 0; j < 4; ++j) den += expf(l4[j] - l4[gi]);
            const float psel = 1.0f / den;
            float le[8]; int i1 = 0;
            for (int j = 0; j < 8; ++j) { const size_t o = (size_t)t * 64 + 4 + gi * 8 + j; le[j] = ((lg[o] + lg[(size_t)NTOK * 64 + o]) + (lg[(size_t)2 * NTOK * 64 + o] + lg[(size_t)3 * NTOK * 64 + o])) * rstd + bre[gi * 8 + j]; }
            for (int j = 1; j < 8; ++j) if (le[j] > le[i1]) i1 = j;
            int i2 = (i1 == 0) ? 1 : 0;
            for (int j = 0; j < 8; ++j) if (j != i1 && le[j] > le[i2]) i2 = j;
            const float w2 = 1.0f / (1.0f + expf(le[i1] - le[i2])), w1 = 1.0f - w2;
            g1 = psel * w1; g2 = psel * w2; e1 = gi * 8 + i1; e2 = gi * 8 + i2;
            p1 = atomicAdd((unsigned*)&lcnt[e1], 1u); p2 = atomicAdd((unsigned*)&lcnt[e2], 1u);
        }
        __syncthreads();
        if (tid < 32) { const unsigned n = lcnt[tid]; lbase[tid] = n ? __hip_atomic_fetch_add(gcnt + tid, n, __ATOMIC_RELAXED, __HIP_MEMORY_SCOPE_AGENT) : 0u; }
        __syncthreads();
        if (tid < 64) {
            unsigned s1 = lbase[e1] + p1, s2 = lbase[e2] + p2; s1 = s1 < (unsigned)ECAP ? s1 : (unsigned)ECAP - 1u; s2 = s2 < (unsigned)ECAP ? s2 : (unsigned)ECAP - 1u;
            const unsigned d1 = (unsigned)e1 * ECAP + s1, d2 = (unsigned)e2 * ECAP + s2;
            tm[TM_DEST + 2 * t] = d1; tm[TM_DEST + 2 * t + 1] = d2; dpair[2 * tid] = d1; dpair[2 * tid + 1] = d2;
            rm[RM_GATE + d1] = g1; rm[RM_GATE + d2] = g2; rsl[tid] = rstd;
        }
        __syncthreads();
#pragma unroll 2
        for (int i = 0; i < 8; ++i) { const int tl = F.wave * 8 + i, tt = tb * 64 + tl; const unsigned d0 = dpair[2 * tl], d1 = dpair[2 * tl + 1]; const float rs = rsl[tl];
            const u32x4* sp = (const u32x4*)(xg + (size_t)tt * LDK) + lane; u32x4 v[8];
#pragma unroll
            for (int j = 0; j < 8; ++j) v[j] = sp[64 * j];
            u32x2* o0 = (u32x2*)(Xs + (size_t)d0 * LDK8) + lane; u32x2* o1 = (u32x2*)(Xs + (size_t)d1 * LDK8) + lane;
#pragma unroll
            for (int j = 0; j < 8; ++j) { const u32x2 f8 = bf16x8_to_fp8(v[j], rs); o0[64 * j] = f8; o1[64 * j] = f8; } }
    }
}
__device__ __forceinline__ int build_tiles(const Frame& F) {
    const int tid = tid_();
    LAS int* ptile = (LAS int*)(F.lds + LDS_TAB + 512); LAS int* tile_e = (LAS int*)(F.lds + LDS_TAB + 1024);
    const unsigned* gcnt = F.ctl + CW_CNT;
    __syncthreads();
    if (tid == 0) { int accu = 0;
        for (int e = 0; e < NE; ++e) { const unsigned c = gcnt[e] < (unsigned)ECAP ? gcnt[e] : (unsigned)ECAP; const int nt = (int)((c + 255u) >> 8); for (int k = 0; k < nt; ++k) tile_e[accu + k] = e * 8 + k; accu += nt; }
        ptile[0] = accu; }
    __syncthreads();
    return __builtin_amdgcn_readfirstlane(ptile[0]);
}
__device__ __forceinline__ void p10_combine(const Frame& F, float* out) {
    const int lane = lane_();
    const unsigned* tm = (const unsigned*)(F.ws + WS_TOK); const unsigned char* Y = F.ws + WS_Y; const bf16_t* x1b = (const bf16_t*)(F.ws + WS_H);
    int t = F.vcu * 8 + F.wave; unsigned d0 = tm[TM_DEST + 2 * t], d1 = tm[TM_DEST + 2 * t + 1];
    for (; t < NTOK; t += F.G * 8) { const int tn = t + F.G * 8; unsigned nd0 = d0, nd1 = d1; if (tn < NTOK) { nd0 = tm[TM_DEST + 2 * tn]; nd1 = tm[TM_DEST + 2 * tn + 1]; }
        const u32x2* y0 = (const u32x2*)(Y + (size_t)d0 * DM) + lane; const u32x2* y1 = (const u32x2*)(Y + (size_t)d1 * DM) + lane; const u32x4* xs = (const u32x4*)(x1b + (size_t)t * LDK) + lane;
        f32x4* o = (f32x4*)(out + (size_t)t * DM) + 2 * lane;
        u32x2 a[8], b[8]; u32x4 xv[8];
#pragma unroll
        for (int j = 0; j < 8; ++j) xv[j] = xs[64 * j];
#pragma unroll
        for (int j = 0; j < 8; ++j) { a[j] = y0[64 * j]; b[j] = y1[64 * j]; }
#pragma unroll
        for (int j = 0; j < 8; ++j) { f32x4 v0, v1;
            v0[0] = __uint_as_float(xv[j][0] << 16) + (__builtin_amdgcn_cvt_f32_fp8((int)a[j][0], 0) + __builtin_amdgcn_cvt_f32_fp8((int)b[j][0], 0)) * (1.0f / Y_SCALE);
            v0[1] = __uint_as_float(xv[j][0] & 0xffff0000u) + (__builtin_amdgcn_cvt_f32_fp8((int)a[j][0], 1) + __builtin_amdgcn_cvt_f32_fp8((int)b[j][0], 1)) * (1.0f / Y_SCALE);
            v0[2] = __uint_as_float(xv[j][1] << 16) + (__builtin_amdgcn_cvt_f32_fp8((int)a[j][0], 2) + __builtin_amdgcn_cvt_f32_fp8((int)b[j][0], 2)) * (1.0f / Y_SCALE);
            v0[3] = __uint_as_float(xv[j][1] & 0xffff0000u) + (__builtin_amdgcn_cvt_f32_fp8((int)a[j][0], 3) + __builtin_amdgcn_cvt_f32_fp8((int)b[j][0], 3)) * (1.0f / Y_SCALE);
            v1[0] = __uint_as_float(xv[j][2] << 16) + (__builtin_amdgcn_cvt_f32_fp8((int)a[j][1], 0) + __builtin_amdgcn_cvt_f32_fp8((int)b[j][1], 0)) * (1.0f / Y_SCALE);
            v1[1] = __uint_as_float(xv[j][2] & 0xffff0000u) + (__builtin_amdgcn_cvt_f32_fp8((int)a[j][1], 1) + __builtin_amdgcn_cvt_f32_fp8((int)b[j][1], 1)) * (1.0f / Y_SCALE);
            v1[2] = __uint_as_float(xv[j][3] << 16) + (__builtin_amdgcn_cvt_f32_fp8((int)a[j][1], 2) + __builtin_amdgcn_cvt_f32_fp8((int)b[j][1], 2)) * (1.0f / Y_SCALE);
            v1[3] = __uint_as_float(xv[j][3] & 0xffff0000u) + (__builtin_amdgcn_cvt_f32_fp8((int)a[j][1], 3) + __builtin_amdgcn_cvt_f32_fp8((int)b[j][1], 3)) * (1.0f / Y_SCALE);
            o[128 * j] = v0; o[128 * j + 1] = v1; }
        d0 = nd0; d1 = nd1; }
}

__global__ void __launch_bounds__(512, 2) mk_fwd(Params P) {
    extern __shared__ __attribute__((aligned(16))) unsigned char lds_raw[];
    Frame F; F.lds = (LAS unsigned char*)lds_raw; F.wave = __builtin_amdgcn_readfirstlane((int)threadIdx.x >> 6);
    F.G = gridDim.x; F.bx = blockIdx.x; F.vcu = (F.G % 8 == 0) ? (F.bx % 8) * (F.G / 8) + F.bx / 8 : F.bx;
    F.ws = P.ws; F.ctl = (unsigned*)(P.ws + WS_CTL);
    volatile LAS unsigned* misc = (volatile LAS unsigned*)(F.lds + LDS_MISC);
    { const int t0 = tid_(); if (t0 < 4) misc[t0] = 0u; }
    __syncthreads();
    XcdBarrier bar; bar.bar = F.ctl + CW_BAR; bar.x = 0; bar.st = misc;
    const int lo = P.ph_lo, hi = P.ph_hi;
    if (hi - lo > 1) bar = xcd_barrier_post(F.ctl + CW_BAR, misc, tid_() == 0);
#define IN(k) (lo <= (k) && (k) < hi)
#define SEAM(k) do { if (IN(k) && IN((k) + 1)) xcd_barrier(bar, tid_() == 0); } while (0)
    LAS unsigned char* stage = F.lds + LDS_STAGE;
    bf16_t* Hb = (bf16_t*)(F.ws + WS_H);

    if (IN(0)) { p0_prologue(F, P); } SEAM(0);
    if (IN(1)) {
        {
            pg8::Shape g{256 / 64, PW * 2, 256 * 2}; pg8::PoolOrder S{(const char*)(F.ws + WS_POOLED), (const char*)(F.ws + WS_GW), F.G, F.bx, 64};
            EpiPool E{F.ws + WS_WOUT, nullptr};
            pg8::gemm_phase<-1, 0x7F7F7F7F, 0x7F7F7F7F>(stage, F.wave, g, S, E); }
        EpiProj E{(bf16_t*)(F.ws + WS_U), (bf16_t*)(F.ws + WS_Q), (bf16_t*)(F.ws + WS_K), (bf16_t*)(F.ws + WS_V), P.in[5], P.in[6], (LAS float*)(F.lds + LDS_XCH), P.flags & 1, 0};
        { pg8::Shape g{DM / 64, LDK * 2, LDK * 2}; pg8::DenseOrder S; S.init(Hb, F.ws + WS_WINU, LDK * 2, LDK * 2, NTOK, PW, F.G, F.bx);
          pg8::gemm_phase<-1, 0x7F7F7F7F, 0x7F7F7F7F>(stage, F.wave, g, S, E); }
        E.pn0 = 4;
        { pg8::Shape g{DM / 128, LDK8, LDK8}; pg8::DenseOrder S; S.init(F.ws + WS_H8, F.ws + WS_WIN8, LDK8, LDK8, NTOK, 3 * AW, F.G, F.bx);
          pg8::gemm_phase<0, 0x77777777, 0x7F7F7F7F>(stage, F.wave, g, S, E); }
    } SEAM(1);
    if (IN(2)) { p2_pooled(F); p2_attention(F, P.in[7]); } SEAM(2);
    if (IN(4)) {
        pg8::Shape g{16 + 24, LDM, LDM}; pg8::DenseOrder S; S.init(F.ws + WS_YCAT, F.ws + WS_WOUT, LDM, LDM, NTOK, DM, F.G, F.bx);
        EpiOut E{P.in[1], (const float*)(F.ws + WS_TOK) + TM_RSTD, Hb, (float*)(F.ws + WS_SSQ), P.flags & 1};
        pg8::gemm_phase<16, 0x77777777, 0x79797979>(stage, F.wave, g, S, E);
    } SEAM(4);
    if (IN(5)) {
        pg8::Shape g{1024 / 64, LDK * 2, LDK * 2}; pg8::RouterOrder S{(const char*)Hb, (const char*)(F.ws + WS_WR), F.G, F.bx};
        EpiLogits E{(float*)(F.ws + WS_LOG)};
        pg8::gemm_phase<-1, 0x7F7F7F7F, 0x7F7F7F7F>(stage, F.wave, g, S, E);
    } SEAM(5);
    if (IN(6)) { p6_route_scatter(F, P); }
    if (IN(6) && IN(8)) xcd_barrier(bar, tid_() == 0);
    if (IN(8)) {
        const int NT = build_tiles(F);
        pg8::Shape g{DM / 128, LDK8, LDK8};
        pg8::GroupedOrder S{(const char*)(F.ws + WS_XS), (const char*)(F.ws + WS_WGU), LDK8, LDK8, NT, 8, 2048, F.G, F.bx, (const LAS int*)(F.lds + LDS_TAB + 1024)};
        EpiSwiglu E{F.ws + WS_ABUF, (const float*)(F.ws + WS_ROW) + RM_GATE};
        pg8::gemm_phase<0, 0x77777777, 0x7F7F7F7F>(stage, F.wave, g, S, E);
    } SEAM(8);
    if (IN(9)) {
        const int NT = build_tiles(F);
        pg8::Shape g{DE / 128, LDE8, LDE8};
        pg8::GroupedOrder S{(const char*)(F.ws + WS_ABUF), (const char*)(F.ws + WS_WD), LDE8, LDE8, NT, 16, DM, F.G, F.bx, (const LAS int*)(F.lds + LDS_TAB + 1024)};
        EpiDown E{F.ws + WS_Y};
        pg8::gemm_phase<0, 0x78787878, -2139062144  >(stage, F.wave, g, S, E);
    } SEAM(9);
    if (IN(10)) { p10_combine(F, P.out); }
#if defined(MK_BURN)
    if (IN(11)) {
        f32x4 c0 = {0.f, 0.f, 0.f, 0.f}, c1 = c0, c2 = c0, c3 = c0; bf16x8 a, b;
        for (int j = 0; j < 8; ++j) { a[j] = (short)(0x3c00 + tid_()); b[j] = (short)(0x3c01 + j); }
#pragma unroll 1
        for (int it = 0; it < 65536 / 8; ++it) {
            c0 = __builtin_amdgcn_mfma_f32_16x16x32_bf16(a, b, c0, 0, 0, 0); c1 = __builtin_amdgcn_mfma_f32_16x16x32_bf16(a, b, c1, 0, 0, 0);
            c2 = __builtin_amdgcn_mfma_f32_16x16x32_bf16(a, b, c2, 0, 0, 0); c3 = __builtin_amdgcn_mfma_f32_16x16x32_bf16(a, b, c3, 0, 0, 0);
            c0 = __builtin_amdgcn_mfma_f32_16x16x32_bf16(a, b, c0, 0, 0, 0); c1 = __builtin_amdgcn_mfma_f32_16x16x32_bf16(a, b, c1, 0, 0, 0);
            c2 = __builtin_amdgcn_mfma_f32_16x16x32_bf16(a, b, c2, 0, 0, 0); c3 = __builtin_amdgcn_mfma_f32_16x16x32_bf16(a, b, c3, 0, 0, 0); }
        const f32x4 r = c0 + c1 + c2 + c3; if (r[0] + r[1] + r[2] + r[3] == 1.2345f) F.ctl[200000] = 1u;
    }
#endif
#undef IN
#undef SEAM
}

#ifdef MK_DBG
__global__ void dbg_dump(const bf16_t* b0, int ld0, const bf16_t* b1, int ld1, const bf16_t* b2, int ld2, const bf16_t* b3, int ld3, float* out) {
    for (size_t i = (size_t)blockIdx.x * blockDim.x + threadIdx.x; i < (size_t)NTOK * DM; i += (size_t)gridDim.x * blockDim.x) {
        const int t = (int)(i >> 12), c = (int)(i & 4095), q = c >> 10, cc = c & 1023;
        const bf16_t* b = q == 0 ? b0 : q == 1 ? b1 : q == 2 ? b2 : b3; const int ld = q == 0 ? ld0 : q == 1 ? ld1 : q == 2 ? ld2 : ld3;
        out[i] = bf2f(b[(size_t)t * ld + cc]); }
}
#endif
extern "C" void kernel_launch(void* const* d_in, const int* in_sizes, int n_in, void* d_out, int out_size, void* d_ws, size_t ws_size, hipStream_t stream) {
    static int grid = 0;
    if (grid == 0) {
        if (n_in != 17 || out_size != NTOK * DM || ws_size < WS_END) { fprintf(stderr, "kernel_launch: unexpected shapes (n_in %d, out %d, ws %zu < %zu)\n", n_in, out_size, ws_size, (size_t)WS_END); grid = -1; return; }
        int dev = 0, cus = 0, per_cu = 0;
        if (hipGetDevice(&dev) != hipSuccess || hipDeviceGetAttribute(&cus, hipDeviceAttributeMultiprocessorCount, dev) != hipSuccess) { grid = -1; return; }
        if (hipFuncSetAttribute((const void*)mk_fwd, hipFuncAttributeMaxDynamicSharedMemorySize, LDS_BYTES) != hipSuccess) { fprintf(stderr, "kernel_launch: hipFuncSetAttribute failed\n"); grid = -1; return; }
        if (hipOccupancyMaxActiveBlocksPerMultiprocessor(&per_cu, (const void*)mk_fwd, 512, LDS_BYTES) != hipSuccess || per_cu < 1) { fprintf(stderr, "kernel_launch: occupancy query says %d\n", per_cu); }
        (void)hipGetLastError();
        grid = cus;
    }
    if (grid < 0) return;
    (void)hipMemsetAsync((char*)d_ws + WS_CTL, 0, CTL_BYTES, stream);
    Params p{};
    for (int i = 0; i < 17; ++i) p.in[i] = (const float*)d_in[i];
    p.out = (float*)d_out; p.ws = (unsigned char*)d_ws;
#if MK_LAUNCHES == 1
    p.ph_lo = 0; p.ph_hi = NPH < MK_STOP ? NPH : MK_STOP;
    hipLaunchKernelGGL(mk_fwd, dim3(grid), dim3(512), LDS_BYTES, stream, p);
#else
    for (int ph = 0; ph < NPH && ph < MK_STOP; ++ph) { p.ph_lo = ph; p.ph_hi = ph + 1; hipLaunchKernelGGL(mk_fwd, dim3(grid), dim3(512), LDS_BYTES, stream, p);
#if defined(MK_BURN)
        if (ph == 4) { p.ph_lo = 11; p.ph_hi = 12; hipLaunchKernelGGL(mk_fwd, dim3(grid), dim3(512), LDS_BYTES, stream, p); }
#endif
        if (ph == MK_REPEAT) { p.flags = MK_REPEAT_FLAGS; hipLaunchKernelGGL(mk_fwd, dim3(grid), dim3(512), LDS_BYTES, stream, p); p.flags = 0; } }
#endif
#ifdef MK_DBG
    { unsigned char* w = (unsigned char*)d_ws;
#if MK_DBG == 1
      hipLaunchKernelGGL(dbg_dump, dim3(2048), dim3(256), 0, stream, (const bf16_t*)(w + WS_U), 1024, (const bf16_t*)(w + WS_Q), 3072, (const bf16_t*)(w + WS_K), 3072, (const bf16_t*)(w + WS_V), 3072, (float*)d_out);
#elif MK_DBG == 0
      hipLaunchKernelGGL(dbg_dump, dim3(2048), dim3(256), 0, stream, (const bf16_t*)(w + WS_H), 4096, (const bf16_t*)(w + WS_H) + 1024, 4096, (const bf16_t*)(w + WS_H) + 2048, 4096, (const bf16_t*)(w + WS_H) + 3072, 4096, (float*)d_out);
#elif MK_DBG == 2
      hipLaunchKernelGGL(dbg_dump, dim3(2048), dim3(256), 0, stream, (const bf16_t*)(w + WS_POOLED), 1024, (const bf16_t*)(w + WS_YCAT) + 1024, 4096, (const bf16_t*)(w + WS_YCAT) + 2048, 4096, (const bf16_t*)(w + WS_YCAT) + 3072, 4096, (float*)d_out);
#endif
    }
#endif
}
```
